# Optimizing an MI355X kernel written in HIP

```python
import jax, jax.numpy as jnp
from jax import lax
import numpy as np

D_MODEL = 4096
BATCH = 4
SEQ = 4096
DEPTH = 1

PLE_DIM = 256
HEAD_DIM = 128
MOBA_HEADS = D_MODEL // (2 * HEAD_DIM)
SB_HEADS = D_MODEL // (2 * HEAD_DIM)
MOBA_WIDTH = MOBA_HEADS * HEAD_DIM
SB_WIDTH = SB_HEADS * HEAD_DIM
MOBA_BLOCK = 256
MOBA_TOPK = 3
MOBA_Q_CHUNK = 16
SB_Q_BLOCK = 128
D_FF = ((8 * D_MODEL // 3 + 255) // 256) * 256
RMS_EPS = 1e-6
IN_SPLITS = [MOBA_WIDTH, MOBA_WIDTH, MOBA_WIDTH, SB_WIDTH, SB_WIDTH, SB_WIDTH, D_MODEL, D_MODEL]
IN_COLS = sum(IN_SPLITS)

kernel_name = "hybrid_moba_stickbreaking_gated_block"


def rms_norm(x, g):
    xf = x.astype(jnp.float32)
    xf = xf * lax.rsqrt(jnp.mean(xf * xf, axis=-1, keepdims=True) + RMS_EPS)
    return xf.astype(x.dtype) * g


def swiglu(x, w_gate, w_up, w_down):
    return (jax.nn.silu(x @ w_gate) * (x @ w_up)) @ w_down


def alibi_slopes(n_heads):
    return jnp.asarray(2.0 ** (-8.0 * np.arange(1, n_heads + 1) / n_heads), dtype=jnp.float32)


def split_heads(t, n_heads):
    b, s, _ = t.shape
    return t.reshape(b, s, n_heads, HEAD_DIM).transpose(0, 2, 1, 3)


def merge_heads(t):
    b, h, s, d = t.shape
    return t.transpose(0, 2, 1, 3).reshape(b, s, h * d)


def moba_attention(q, k, v):
    B, H, S, dh = q.shape
    L = MOBA_BLOCK
    nb = -(-S // L)
    pad = nb * L - S
    k_pad = jnp.pad(k, ((0, 0), (0, 0), (0, pad), (0, 0)))
    v_pad = jnp.pad(v, ((0, 0), (0, 0), (0, pad), (0, 0)))
    kb = k_pad.reshape(B, H, nb, L, dh)
    vb = v_pad.reshape(B, H, nb, L, dh)
    counts = np.minimum(L, S - np.arange(nb) * L).astype(np.float32)
    k_mean = kb.astype(jnp.float32).sum(axis=3) / jnp.asarray(counts)[:, None]
    gate = jnp.einsum('bhsd,bhnd->bhsn', q.astype(jnp.float32), k_mean)
    q_block = jnp.arange(S) // L
    fully_past = jnp.arange(nb)[None, :] < q_block[:, None]
    gate = jnp.where(fully_past, gate, -jnp.inf)
    n_sel = min(MOBA_TOPK, nb)
    _, sel = lax.top_k(gate, n_sel)
    sel_ok = sel < q_block[:, None]

    scale = dh ** -0.5
    slopes = alibi_slopes(H)
    C = MOBA_Q_CHUNK
    bi = jnp.arange(B)[:, None, None, None]
    hi = jnp.arange(H)[None, :, None, None]

    def chunk(c):
        t0 = c * C
        qc = lax.dynamic_slice_in_dim(q, t0, C, axis=2)
        sc = lax.dynamic_slice_in_dim(sel, t0, C, axis=2)
        okc = lax.dynamic_slice_in_dim(sel_ok, t0, C, axis=2)
        t = (t0 + jnp.arange(C)).astype(jnp.float32)
        k_sel = kb[bi, hi, sc]
        v_sel = vb[bi, hi, sc]
        s_sel = (sc[..., None] * L + jnp.arange(L)).astype(jnp.float32)
        logit_sel = (jnp.einsum('bhcd,bhcnld->bhcnl', qc, k_sel).astype(jnp.float32) * scale
                     - slopes[:, None, None, None] * jnp.abs(t[:, None, None] - s_sel))
        logit_sel = jnp.where(okc[..., None], logit_sel, -jnp.inf)
        b0 = t0 // L
        k_own = lax.dynamic_slice_in_dim(k_pad, b0 * L, L, axis=2)
        v_own = lax.dynamic_slice_in_dim(v_pad, b0 * L, L, axis=2)
        s_own = (b0 * L + jnp.arange(L)).astype(jnp.float32)
        logit_own = (jnp.einsum('bhcd,bhld->bhcl', qc, k_own).astype(jnp.float32) * scale
                     - slopes[:, None, None] * jnp.abs(t[:, None] - s_own[None, :]))
        logit_own = jnp.where(s_own[None, :] <= t[:, None], logit_own, -jnp.inf)
        logits = jnp.concatenate([logit_sel.reshape(B, H, C, n_sel * L), logit_own], axis=-1)
        probs = jax.nn.softmax(logits, axis=-1)
        p_sel = probs[..., :n_sel * L].reshape(B, H, C, n_sel, L).astype(v.dtype)
        p_own = probs[..., n_sel * L:].astype(v.dtype)
        return (jnp.einsum('bhcnl,bhcnld->bhcd', p_sel, v_sel)
                + jnp.einsum('bhcl,bhld->bhcd', p_own, v_own))

    outs = lax.map(chunk, jnp.arange(S // C))
    return outs.transpose(1, 2, 0, 3, 4).reshape(B, H, S, dh)


def stick_breaking_attention(q, k, v):
    B, H, S, dh = q.shape
    scale = dh ** -0.5
    outs = []
    for i in range(S // SB_Q_BLOCK):
        t0, t1 = i * SB_Q_BLOCK, (i + 1) * SB_Q_BLOCK
        z = jnp.einsum('bhqd,bhsd->bhqs', q[:, :, t0:t1], k[:, :, :t1]).astype(jnp.float32) * scale
        t = jnp.arange(t0, t1)
        s = jnp.arange(t1)
        strict = s[None, :] < t[:, None]
        log_keep = jnp.where(strict, jax.nn.log_sigmoid(-z), 0.0)
        later = lax.cumsum(log_keep, axis=3, reverse=True) - log_keep
        w = jnp.where(strict, jnp.exp(jax.nn.log_sigmoid(z) + later), 0.0)
        outs.append(jnp.einsum('bhqs,bhsd->bhqd', w.astype(v.dtype), v[:, :, :t1]))
    return jnp.concatenate(outs, axis=2)


def setup_inputs(seed: int = 0) -> dict:
    key = jax.random.key(seed)
    ks = jax.random.split(key, 24)
    f32 = jnp.float32

    def w(k, shape, fan_in):
        return jax.random.normal(k, shape, f32) * (fan_in ** -0.5)

    def gain(k, shape):
        return 1.0 + 0.02 * jax.random.normal(k, shape, f32)

    return {
        "x": jax.random.normal(ks[0], (BATCH, SEQ, D_MODEL), f32),
        "p": jax.random.normal(ks[1], (DEPTH, BATCH, SEQ, PLE_DIM), f32),
        "ffn1_norm": gain(ks[2], (DEPTH, D_MODEL)),
        "ffn1_w_gate": w(ks[3], (DEPTH, D_MODEL, D_FF), D_MODEL),
        "ffn1_w_up": w(ks[4], (DEPTH, D_MODEL, D_FF), D_MODEL),
        "ffn1_w_down": w(ks[5], (DEPTH, D_FF, D_MODEL), D_FF),
        "mix_norm": gain(ks[6], (DEPTH, D_MODEL)),
        "w_in": w(ks[7], (DEPTH, D_MODEL, IN_COLS), D_MODEL),
        "w_branch_moba": w(ks[8], (DEPTH, MOBA_WIDTH, D_MODEL), MOBA_WIDTH),
        "w_branch_sb": w(ks[9], (DEPTH, SB_WIDTH, D_MODEL), SB_WIDTH),
        "w_out": w(ks[10], (DEPTH, D_MODEL, D_MODEL), D_MODEL),
        "ffn2_norm": gain(ks[11], (DEPTH, D_MODEL)),
        "ffn2_w_gate": w(ks[12], (DEPTH, D_MODEL, D_FF), D_MODEL),
        "ffn2_w_up": w(ks[13], (DEPTH, D_MODEL, D_FF), D_MODEL),
        "ffn2_w_down": w(ks[14], (DEPTH, D_FF, D_MODEL), D_FF),
        "ple_norm": gain(ks[15], (DEPTH, D_MODEL)),
        "w_ple_gate": w(ks[16], (DEPTH, D_MODEL, D_MODEL), D_MODEL),
        "w_ple_proj": w(ks[17], (DEPTH, PLE_DIM, D_MODEL), PLE_DIM),
        "final_norm": gain(ks[18], (D_MODEL,)),
    }


def reference(x, p, ffn1_norm, ffn1_w_gate, ffn1_w_up, ffn1_w_down, mix_norm, w_in,
              w_branch_moba, w_branch_sb, w_out, ffn2_norm, ffn2_w_gate, ffn2_w_up,
              ffn2_w_down, ple_norm, w_ple_gate, w_ple_proj, final_norm):
    h = x
    offsets = [int(o) for o in np.cumsum(IN_SPLITS)[:-1]]
    for i in range(DEPTH):
        h = h + 0.5 * swiglu(rms_norm(h, ffn1_norm[i]), ffn1_w_gate[i], ffn1_w_up[i], ffn1_w_down[i])
        u = rms_norm(h, mix_norm[i])
        qa, ka, va, qb, kb, vb, ga, gb = jnp.split(u @ w_in[i], offsets, axis=-1)
        y_a = merge_heads(moba_attention(split_heads(qa, MOBA_HEADS), split_heads(ka, MOBA_HEADS),
                                         split_heads(va, MOBA_HEADS))) @ w_branch_moba[i]
        y_b = merge_heads(stick_breaking_attention(split_heads(qb, SB_HEADS), split_heads(kb, SB_HEADS),
                                                   split_heads(vb, SB_HEADS))) @ w_branch_sb[i]
        h = h + (jax.nn.sigmoid(ga) * y_a + jax.nn.sigmoid(gb) * y_b) @ w_out[i]
        h = h + 0.5 * swiglu(rms_norm(h, ffn2_norm[i]), ffn2_w_gate[i], ffn2_w_up[i], ffn2_w_down[i])
        h = h + jax.nn.sigmoid(rms_norm(h, ple_norm[i]) @ w_ple_gate[i]) * (p[i] @ w_ple_proj[i])
    return rms_norm(h, final_norm)
```

```cpp
#include <hip/hip_runtime.h>
#include <cstdio>
#include <cstdint>
#include <cmath>
namespace pg8 {
#define PG8_LAS __attribute__((address_space(3)))
typedef unsigned short bf16_t;
typedef short bf16x8 __attribute__((ext_vector_type(8)));
typedef float f32x4 __attribute__((ext_vector_type(4)));
typedef unsigned u32x4 __attribute__((ext_vector_type(4)));
constexpr int BM = 256, BK = 64, HALF = 128, HTB = HALF * BK * 2  , STAGE_BYTES = 8 * HTB, NXCD = 8;

__host__ __device__ __forceinline__ int lds_byte(int r, int c) { const int st = (r >> 4) * 2 + (c >> 5), rr = r & 15, cc = c & 31, ob = rr * 64 + cc * 2; return st * 1024 + (ob ^ (((ob >> 9) & 1) << 5)); }
__host__ __device__ __forceinline__ void stage_rc(int b, int& R, int& C) { const int st = b / 1024, sb = b % 1024, swz = sb ^ (((sb >> 9) & 1) << 5); R = (st >> 1) * 16 + swz / 64; C = (st & 1) * 32 + (swz % 64) / 2; }
__host__ __device__ __forceinline__ int perm32(int rho) { const int n = rho >> 4, i = rho & 15; return 8 * (i >> 2) + 4 * n + (i & 3); }

struct Unit { int pm, pn; };
struct Gemm { const bf16_t* A; const bf16_t* Bt; int M, N, K, lda, ldb; int pmulA = 1, pmulB = 1; int krev = 0; };

struct StaticOrder {
    int nM, nN, nwg, G, c, WGM, L0, Lend;
    __host__ __device__ __forceinline__ void init(int M, int N, int G_, int c_, int wgm = 8) { nM = M / BM; nN = N / BM; nwg = nM * nN; G = G_; c = c_; WGM = wgm; L0 = 0; Lend = nwg; }
    __host__ __device__ __forceinline__ bool next(int i, Unit& u) const {
        const long L = (long)L0 + (long)i * G + c; if (L >= Lend) return false;
        int wgid = (int)L; { const int q = nwg / NXCD, r = nwg % NXCD, xcd = wgid % NXCD, off = wgid / NXCD; wgid = (xcd < r ? xcd * (q + 1) : r * (q + 1) + (xcd - r) * q) + off; }
        const int nig = WGM * nN, gid = wgid / nig, fm = gid * WGM, gsz = (nM - fm) < WGM ? (nM - fm) : WGM;
        u.pm = fm + ((wgid % nig) % gsz); u.pn = (wgid % nig) / gsz; return true;
    }
    __device__ __forceinline__ void a_ready(const Unit&) const {}
    __device__ __forceinline__ void done(const Unit&) const {}
};

__device__ __forceinline__ unsigned cvt_pk_bf16(float lo, float hi) { unsigned r; asm volatile("v_cvt_pk_bf16_f32 %0, %1, %2" : "=v"(r) : "v"(lo), "v"(hi)); return r; }
typedef unsigned u32x2 __attribute__((ext_vector_type(2)));
__device__ __forceinline__ float sigm(float x) { return __builtin_amdgcn_rcpf(1.0f + __builtin_amdgcn_exp2f(-1.4426950408889634f * x)); }
__device__ __forceinline__ float bf_lo(unsigned w) { return __uint_as_float(w << 16); }
__device__ __forceinline__ float bf_hi(unsigned w) { return __uint_as_float(w & 0xffff0000u); }

struct RowScale { const float* SS; const PG8_LAS float* rsl; int pm0; };
__device__ __forceinline__ void load_rstd(float (&rs)[2][4], const RowScale& R, int pm, int r0) {
    if (!R.SS) {
#pragma unroll
        for (int ai = 0; ai < 2; ++ai)
#pragma unroll
            for (int m = 0; m < 4; ++m) rs[ai][m] = 1.0f;
        return; }
    if (pm == R.pm0) {
#pragma unroll
        for (int ai = 0; ai < 2; ++ai)
#pragma unroll
            for (int m = 0; m < 4; ++m) rs[ai][m] = R.rsl[r0 + ai * HALF + m * 16];
        return; }
#pragma unroll
    for (int ai = 0; ai < 2; ++ai)
#pragma unroll
        for (int m = 0; m < 4; ++m) rs[ai][m] = __builtin_amdgcn_rsqf(R.SS[pm * BM + r0 + ai * HALF + m * 16] * (1.0f / 4096.0f) + 1e-6f);
}
struct EpiBf16 {
    static constexpr bool PERM = true, AFTER_DRAIN = false;
    bf16_t* O; int ldc; RowScale RS; size_t ts; int split; bf16_t* O2; int ldc2;
    __device__ __forceinline__ void operator()(const f32x4 (&acc)[2][2][4][2], const Unit& u, int wr, int wc, int fr, int fq) const {
        const bool first = u.pn < split;
        const int row0 = u.pm * BM + wr * 64 + fr, cw = wc * 32 + 8 * fq, ld = first ? ldc : ldc2;
        bf16_t* tb = first ? O + (size_t)u.pn * ts : O2 + (size_t)(u.pn - split) * BM;
        float rsv[2][4]; load_rstd(rsv, RS, u.pm, wr * 64 + fr);
#pragma unroll
        for (int ai = 0; ai < 2; ++ai)
#pragma unroll
            for (int m = 0; m < 4; ++m) { const int row = row0 + ai * HALF + m * 16; bf16_t* rowp = tb + (size_t)row * ld + cw; const float r = rsv[ai][m];
#pragma unroll
                for (int bj = 0; bj < 2; ++bj) { const f32x4 v0 = acc[ai][bj][m][0] * r, v1 = acc[ai][bj][m][1] * r;
                    u32x4 w; w.x = cvt_pk_bf16(v0[0], v0[1]); w.y = cvt_pk_bf16(v0[2], v0[3]); w.z = cvt_pk_bf16(v1[0], v1[1]); w.w = cvt_pk_bf16(v1[2], v1[3]);
                    *(u32x4*)(rowp + bj * HALF) = w; } }
    }
};
struct EpiSwiGLU {
    static constexpr bool PERM = true, AFTER_DRAIN = false;
    bf16_t* O; int ldc; RowScale RS;
    __device__ __forceinline__ void operator()(const f32x4 (&acc)[2][2][4][2], const Unit& u, int wr, int wc, int fr, int fq) const {
        const int row0 = u.pm * BM + wr * 64 + fr, col0 = u.pn * HALF + wc * 32 + 8 * fq;
        float rsv[2][4]; load_rstd(rsv, RS, u.pm, wr * 64 + fr);
#pragma unroll
        for (int ai = 0; ai < 2; ++ai)
#pragma unroll
            for (int m = 0; m < 4; ++m) { const int row = row0 + ai * HALF + m * 16; bf16_t* rowp = O + (size_t)row * ldc + col0; const float rs = rsv[ai][m];
                const float ka = -1.4426950408889634f * rs, kb = rs * rs;
                const f32x4 g0 = acc[ai][0][m][0], g1 = acc[ai][0][m][1], u0 = acc[ai][1][m][0], u1 = acc[ai][1][m][1];
                f32x4 e0 = g0 * ka, e1 = g1 * ka;
#pragma unroll
                for (int j = 0; j < 4; ++j) { e0[j] = __builtin_amdgcn_exp2f(e0[j]); e1[j] = __builtin_amdgcn_exp2f(e1[j]); }
                e0 = e0 + 1.0f; e1 = e1 + 1.0f;
#pragma unroll
                for (int j = 0; j < 4; ++j) { e0[j] = __builtin_amdgcn_rcpf(e0[j]); e1[j] = __builtin_amdgcn_rcpf(e1[j]); }
                const f32x4 t0 = ((g0 * u0) * kb) * e0, t1 = ((g1 * u1) * kb) * e1;
                u32x4 w; w.x = cvt_pk_bf16(t0[0], t0[1]); w.y = cvt_pk_bf16(t0[2], t0[3]); w.z = cvt_pk_bf16(t1[0], t1[1]); w.w = cvt_pk_bf16(t1[2], t1[3]);
                *(u32x4*)rowp = w; }
    }
};
struct EpiResidBf {
    static constexpr bool PERM = true, AFTER_DRAIN = false;
    const bf16_t* Hin; bf16_t* Hout; int ldc; float alpha; float* SS;
    __device__ __forceinline__ void operator()(const f32x4 (&acc)[2][2][4][2], const Unit& u, int wr, int wc, int fr, int fq) const {
        const int row0 = u.pm * BM + wr * 64 + fr, col0 = u.pn * BM + wc * 32 + 8 * fq;
        u32x4 hw[2][4][2];
#pragma unroll
        for (int ai = 0; ai < 2; ++ai)
#pragma unroll
            for (int m = 0; m < 4; ++m)
#pragma unroll
                for (int bj = 0; bj < 2; ++bj) hw[ai][m][bj] = *(const u32x4*)(Hin + (size_t)(row0 + ai * HALF + m * 16) * ldc + col0 + bj * HALF);
#pragma unroll
        for (int ai = 0; ai < 2; ++ai)
#pragma unroll
            for (int m = 0; m < 4; ++m) { const int row = row0 + ai * HALF + m * 16; float ssq = 0.f;
#pragma unroll
                for (int bj = 0; bj < 2; ++bj) { const size_t p = (size_t)row * ldc + col0 + bj * HALF; float r[8]; const u32x4 h4 = hw[ai][m][bj];
                    r[0] = bf_lo(h4.x); r[1] = bf_hi(h4.x); r[2] = bf_lo(h4.y); r[3] = bf_hi(h4.y); r[4] = bf_lo(h4.z); r[5] = bf_hi(h4.z); r[6] = bf_lo(h4.w); r[7] = bf_hi(h4.w);
                    const f32x4 v0 = acc[ai][bj][m][0], v1 = acc[ai][bj][m][1];
#pragma unroll
                    for (int j = 0; j < 4; ++j) { r[j] += alpha * v0[j]; r[4 + j] += alpha * v1[j]; }
#pragma unroll
                    for (int j = 0; j < 8; ++j) ssq += r[j] * r[j];
                    u32x4 w; w.x = cvt_pk_bf16(r[0], r[1]); w.y = cvt_pk_bf16(r[2], r[3]); w.z = cvt_pk_bf16(r[4], r[5]); w.w = cvt_pk_bf16(r[6], r[7]);
                    *(u32x4*)(Hout + p) = w; }
                ssq += __shfl_xor(ssq, 16); ssq += __shfl_xor(ssq, 32);
                if (fq == 0) (void)__hip_atomic_fetch_add(SS + row, ssq, __ATOMIC_RELAXED, __HIP_MEMORY_SCOPE_AGENT); }
    }
};
struct EpiPleOut {
    static constexpr bool PERM = true, AFTER_DRAIN = false;
    const bf16_t* H; const bf16_t* PE; bf16_t* O; int ldc; RowScale RS;
    __device__ __forceinline__ void operator()(const f32x4 (&acc)[2][2][4][2], const Unit& u, int wr, int wc, int fr, int fq) const {
        const int row0 = u.pm * BM + wr * 64 + fr, col0 = u.pn * BM + wc * 32 + 8 * fq;
        float rsv[2][4]; load_rstd(rsv, RS, u.pm, wr * 64 + fr);
#pragma unroll
        for (int ai = 0; ai < 2; ++ai) {
            u32x4 hq[4][2], pq[4][2];
#pragma unroll
            for (int m = 0; m < 4; ++m)
#pragma unroll
                for (int bj = 0; bj < 2; ++bj) { const size_t p = (size_t)(row0 + ai * HALF + m * 16) * ldc + col0 + bj * HALF; hq[m][bj] = *(const u32x4*)(H + p); pq[m][bj] = *(const u32x4*)(PE + p); }
#pragma unroll
            for (int m = 0; m < 4; ++m) { const int row = row0 + ai * HALF + m * 16; const float rs = rsv[ai][m];
#pragma unroll
                for (int bj = 0; bj < 2; ++bj) { const size_t p = (size_t)row * ldc + col0 + bj * HALF; const u32x4 hw = hq[m][bj], pw = pq[m][bj];
                    const float ka = -1.4426950408889634f * rs;
                    f32x4 e0 = acc[ai][bj][m][0] * ka, e1 = acc[ai][bj][m][1] * ka;
#pragma unroll
                    for (int j = 0; j < 4; ++j) { e0[j] = __builtin_amdgcn_exp2f(e0[j]); e1[j] = __builtin_amdgcn_exp2f(e1[j]); }
                    e0 = e0 + 1.0f; e1 = e1 + 1.0f;
#pragma unroll
                    for (int j = 0; j < 4; ++j) { e0[j] = __builtin_amdgcn_rcpf(e0[j]); e1[j] = __builtin_amdgcn_rcpf(e1[j]); }
                    const f32x4 h0 = {bf_lo(hw.x), bf_hi(hw.x), bf_lo(hw.y), bf_hi(hw.y)}, h1 = {bf_lo(hw.z), bf_hi(hw.z), bf_lo(hw.w), bf_hi(hw.w)};
                    const f32x4 q0 = {bf_lo(pw.x), bf_hi(pw.x), bf_lo(pw.y), bf_hi(pw.y)}, q1 = {bf_lo(pw.z), bf_hi(pw.z), bf_lo(pw.w), bf_hi(pw.w)};
                    const f32x4 o0 = h0 + e0 * q0, o1 = h1 + e1 * q1;
                    u32x4 w; w.x = cvt_pk_bf16(o0[0], o0[1]); w.y = cvt_pk_bf16(o0[2], o0[3]); w.z = cvt_pk_bf16(o1[0], o1[1]); w.w = cvt_pk_bf16(o1[2], o1[3]);
                    *(u32x4*)(O + p) = w; } } }
    }
};
template <bool ACCUM> struct EpiGate {
    static constexpr bool PERM = true, AFTER_DRAIN = false;
    const bf16_t* G; int ldg; bf16_t* Z; int ldz;
    __device__ __forceinline__ void operator()(const f32x4 (&acc)[2][2][4][2], const Unit& u, int wr, int wc, int fr, int fq) const {
        const int row0 = u.pm * BM + wr * 64 + fr, col0 = u.pn * BM + wc * 32 + 8 * fq;
#pragma unroll
        for (int ai = 0; ai < 2; ++ai) {
            u32x4 gq[4][2], zq[4][2];
#pragma unroll
            for (int m = 0; m < 4; ++m)
#pragma unroll
                for (int bj = 0; bj < 2; ++bj) { const size_t row = (size_t)(row0 + ai * HALF + m * 16); gq[m][bj] = *(const u32x4*)(G + row * ldg + col0 + bj * HALF);
                    if (ACCUM) zq[m][bj] = *(const u32x4*)(Z + row * ldz + col0 + bj * HALF); }
#pragma unroll
            for (int m = 0; m < 4; ++m) { const size_t row = (size_t)(row0 + ai * HALF + m * 16);
#pragma unroll
                for (int bj = 0; bj < 2; ++bj) { const u32x4 gw = gq[m][bj]; bf16_t* zp = Z + row * ldz + col0 + bj * HALF;
                    const f32x4 v0 = acc[ai][bj][m][0], v1 = acc[ai][bj][m][1];
                    f32x4 e0 = {bf_lo(gw.x), bf_hi(gw.x), bf_lo(gw.y), bf_hi(gw.y)}, e1 = {bf_lo(gw.z), bf_hi(gw.z), bf_lo(gw.w), bf_hi(gw.w)};
                    e0 = e0 * -1.4426950408889634f; e1 = e1 * -1.4426950408889634f;
#pragma unroll
                    for (int j = 0; j < 4; ++j) { e0[j] = __builtin_amdgcn_exp2f(e0[j]); e1[j] = __builtin_amdgcn_exp2f(e1[j]); }
                    e0 = e0 + 1.0f; e1 = e1 + 1.0f;
#pragma unroll
                    for (int j = 0; j < 4; ++j) { e0[j] = __builtin_amdgcn_rcpf(e0[j]); e1[j] = __builtin_amdgcn_rcpf(e1[j]); }
                    f32x4 r0 = e0 * v0, r1 = e1 * v1;
                    if (ACCUM) { const u32x4 zw = zq[m][bj];
                        r0 = r0 + (f32x4){bf_lo(zw.x), bf_hi(zw.x), bf_lo(zw.y), bf_hi(zw.y)}; r1 = r1 + (f32x4){bf_lo(zw.z), bf_hi(zw.z), bf_lo(zw.w), bf_hi(zw.w)}; }
                    u32x4 w; w.x = cvt_pk_bf16(r0[0], r0[1]); w.y = cvt_pk_bf16(r0[2], r0[3]); w.z = cvt_pk_bf16(r1[0], r1[1]); w.w = cvt_pk_bf16(r1[2], r1[3]);
                    *(u32x4*)zp = w; } } }
    }
};

template <class Epi, class Sched, bool ALIGN_EPI = false, bool SP2 = false>
__device__ __forceinline__ void gemm_phase(PG8_LAS unsigned char* lds, const Gemm g, const Sched& S, const Epi& E) {
    const int tid = threadIdx.x, wid = __builtin_amdgcn_readfirstlane(tid >> 6), lane = tid & 63, wr = wid >> 2, wc = wid & 3, fr = lane & 15, fq = lane >> 4;
    const int K = g.K, nt = K / BK;
    unsigned voffA[2], voffB[2];
#pragma unroll
    for (int i = 0; i < 2; ++i) { int R, C; stage_rc(tid * 16 + i * 8192, R, C); const int Rb = Epi::PERM ? ((R & ~31) + perm32(R & 31)) : R;
        voffA[i] = (unsigned)(R * g.lda + C) * 2u; voffB[i] = (unsigned)(Rb * g.ldb + C) * 2u; }
    const long kstep = g.krev ? -(long)(BK * 2) : (long)(BK * 2);
    const size_t kfirst = g.krev ? (size_t)(K / BK - 1) * (BK * 2) : 0;
    const size_t hstepA = (size_t)HALF * g.lda * 2, hstepB = (size_t)HALF * g.ldb * 2;
    const size_t tstepA = 2 * hstepA, tstepB = 2 * hstepB;
    const unsigned ldsw = (unsigned)wid * 1024u;
    const int aoff = lds_byte(wr * 64 + fr, fq * 8), boff = lds_byte(wc * 32 + fr, fq * 8);
#define PG8_SA(b, h) (((b) * 2 + (h)) * HTB)
#define PG8_SB(b, h) ((4 + (b) * 2 + (h)) * HTB)
#define PG8_STAGE(bufoff, gbase, voff) do { _Pragma("unroll") for (int _i = 0; _i < 2; ++_i) \
        __builtin_amdgcn_global_load_lds((const unsigned*)((const char*)(gbase) + (voff)[_i]), (PG8_LAS unsigned*)(lds + (bufoff) + ldsw + _i * 8192), 16, 0, 0); } while (0)
#define PG8_LDA(dst, b, h) do { _Pragma("unroll") for (int m = 0; m < 4; ++m) _Pragma("unroll") for (int k = 0; k < 2; ++k) dst[m][k] = *(const PG8_LAS bf16x8*)(lds + PG8_SA(b, h) + aoff + m * 2048 + k * 1024); } while (0)
#define PG8_LDB(dst, b, h) do { _Pragma("unroll") for (int n = 0; n < 2; ++n) _Pragma("unroll") for (int k = 0; k < 2; ++k) dst[n][k] = *(const PG8_LAS bf16x8*)(lds + PG8_SB(b, h) + boff + n * 2048 + k * 1024); } while (0)
#define PG8_MMA(ai, bj, At, Bt) do { __builtin_amdgcn_s_setprio(1); _Pragma("unroll") for (int k = 0; k < 2; ++k) _Pragma("unroll") for (int m = 0; m < 4; ++m) _Pragma("unroll") for (int nn = 0; nn < 2; ++nn) { const int n = (m & 1) ? 1 - nn : nn; \
        acc[ai][bj][m][n] = __builtin_amdgcn_mfma_f32_16x16x32_bf16(Bt[n][k], At[m][k], acc[ai][bj][m][n], 0, 0, 0); } __builtin_amdgcn_s_setprio(0); } while (0)
#define PG8_WAIT_V(n) asm volatile("s_waitcnt vmcnt(" #n ")" ::: "memory")
#define PG8_WAIT_L(n) asm volatile("s_waitcnt lgkmcnt(" #n ")" ::: "memory")
#define PG8_BAR __builtin_amdgcn_s_barrier()
#define PG8_SCHED __builtin_amdgcn_sched_barrier(0)
    Unit cur, nxt; int ui = 0;
    if (!S.next(0, cur)) return;
    f32x4 acc[2][2][4][2];
#pragma unroll
    for (int a = 0; a < 2; ++a)
#pragma unroll
        for (int b = 0; b < 2; ++b)
#pragma unroll
            for (int m = 0; m < 4; ++m)
#pragma unroll
                for (int n = 0; n < 2; ++n) acc[a][b][m][n] = (f32x4){0.f, 0.f, 0.f, 0.f};
    bf16x8 At[4][2], B0[2][2], B1[2][2];
    const char* cA = (const char*)g.A + (size_t)(cur.pm * g.pmulA) * tstepA + kfirst; const char* cB = (const char*)g.Bt + (size_t)(cur.pn * g.pmulB) * tstepB + kfirst;
    S.a_ready(cur);
    if constexpr (SP2) {
        PG8_STAGE(PG8_SB(0, 0), cB, voffB); PG8_STAGE(PG8_SB(0, 1), cB + hstepB, voffB); PG8_STAGE(PG8_SA(0, 0), cA, voffA); PG8_STAGE(PG8_SA(0, 1), cA + hstepA, voffA);
        if (wr == 1) PG8_BAR;
        PG8_WAIT_V(2); PG8_BAR;
        PG8_STAGE(PG8_SB(1, 0), cB + kstep, voffB); PG8_STAGE(PG8_SA(1, 0), cA + kstep, voffA); PG8_STAGE(PG8_SB(1, 1), cB + hstepB + kstep, voffB);
        PG8_WAIT_V(6); PG8_BAR;
    } else {
        PG8_STAGE(PG8_SB(0, 0), cB, voffB); PG8_STAGE(PG8_SA(0, 0), cA, voffA); PG8_STAGE(PG8_SB(0, 1), cB + hstepB, voffB); PG8_STAGE(PG8_SA(0, 1), cA + hstepA, voffA);
        if (wr == 1) PG8_BAR;
        PG8_WAIT_V(4); PG8_BAR;
        PG8_STAGE(PG8_SB(1, 0), cB + kstep, voffB); PG8_STAGE(PG8_SA(1, 0), cA + kstep, voffA); PG8_STAGE(PG8_SB(1, 1), cB + hstepB + kstep, voffB);
        PG8_WAIT_V(6); PG8_BAR;
    }
    for (;;) {
        const bool has_next = S.next(ui + 1, nxt);
        const char* nA = has_next ? (const char*)g.A + (size_t)(nxt.pm * g.pmulA) * tstepA + kfirst : cA; const char* nB = has_next ? (const char*)g.Bt + (size_t)(nxt.pn * g.pmulB) * tstepB + kfirst : cB;
        for (int t = 0; t < nt; t += 2) {
            const bool last = (t == nt - 2);
            const char* a1 = cA + (long)(t + 1) * kstep;
            const char* a2 = last ? nA : cA + (long)(t + 2) * kstep; const char* b2 = last ? nB : cB + (long)(t + 2) * kstep;
            const char* a3 = a2 + kstep; const char* b3 = b2 + kstep;
            if (last && has_next) S.a_ready(nxt);
            if constexpr (SP2) {
            PG8_LDB(B0, 0, 0); PG8_LDB(B1, 0, 1); PG8_SCHED; PG8_LDA(At, 0, 0); PG8_STAGE(PG8_SA(1, 1), a1 + hstepA, voffA);
            PG8_WAIT_V(8); PG8_WAIT_L(0); PG8_BAR; PG8_MMA(0, 0, At, B0); PG8_MMA(0, 1, At, B1); PG8_BAR; PG8_SCHED;
            PG8_LDA(At, 0, 1); PG8_STAGE(PG8_SB(0, 0), b2, voffB); PG8_STAGE(PG8_SB(0, 1), b2 + hstepB, voffB); PG8_STAGE(PG8_SA(0, 0), a2, voffA);
            PG8_WAIT_V(8); PG8_WAIT_L(0); PG8_BAR; PG8_MMA(1, 0, At, B0); PG8_MMA(1, 1, At, B1); PG8_BAR; PG8_SCHED;
            PG8_LDB(B0, 1, 0); PG8_LDB(B1, 1, 1); PG8_SCHED; PG8_LDA(At, 1, 0); PG8_STAGE(PG8_SA(0, 1), a2 + hstepA, voffA);
            PG8_WAIT_V(8); PG8_WAIT_L(0); PG8_BAR; PG8_MMA(0, 0, At, B0); PG8_MMA(0, 1, At, B1); PG8_BAR; PG8_SCHED;
            PG8_LDA(At, 1, 1); PG8_STAGE(PG8_SB(1, 0), b3, voffB); PG8_STAGE(PG8_SB(1, 1), b3 + hstepB, voffB); PG8_STAGE(PG8_SA(1, 0), a3, voffA);
            PG8_WAIT_V(8); PG8_WAIT_L(0); PG8_BAR; PG8_MMA(1, 0, At, B0); PG8_MMA(1, 1, At, B1); PG8_BAR; PG8_SCHED;
            } else {
            PG8_LDB(B0, 0, 0); PG8_SCHED; PG8_LDA(At, 0, 0); PG8_STAGE(PG8_SA(1, 1), a1 + hstepA, voffA);
            PG8_WAIT_L(8); PG8_BAR; PG8_WAIT_L(0); PG8_MMA(0, 0, At, B0); PG8_BAR; PG8_SCHED;
            PG8_LDB(B1, 0, 1); PG8_STAGE(PG8_SB(0, 0), b2, voffB);
            PG8_BAR; PG8_WAIT_L(0); PG8_MMA(0, 1, At, B1); PG8_BAR;
            PG8_LDA(At, 0, 1); PG8_STAGE(PG8_SA(0, 0), a2, voffA);
            PG8_BAR; PG8_WAIT_L(0); PG8_MMA(1, 0, At, B0); PG8_BAR; PG8_SCHED;
            PG8_STAGE(PG8_SB(0, 1), b2 + hstepB, voffB);
            PG8_WAIT_V(6); PG8_BAR; PG8_MMA(1, 1, At, B1); PG8_BAR;
            PG8_LDB(B0, 1, 0); PG8_SCHED; PG8_LDA(At, 1, 0); PG8_STAGE(PG8_SA(0, 1), a2 + hstepA, voffA);
            PG8_WAIT_L(8); PG8_BAR; PG8_WAIT_L(0); PG8_MMA(0, 0, At, B0); PG8_BAR; PG8_SCHED;
            PG8_LDB(B1, 1, 1); PG8_STAGE(PG8_SB(1, 0), b3, voffB);
            PG8_BAR; PG8_WAIT_L(0); PG8_MMA(0, 1, At, B1); PG8_BAR;
            PG8_LDA(At, 1, 1); PG8_STAGE(PG8_SA(1, 0), a3, voffA);
            PG8_BAR; PG8_WAIT_L(0); PG8_MMA(1, 0, At, B0); PG8_BAR; PG8_SCHED;
            PG8_STAGE(PG8_SB(1, 1), b3 + hstepB, voffB);
            PG8_WAIT_V(6); PG8_BAR; PG8_MMA(1, 1, At, B1); PG8_BAR;
            }
        }
        if constexpr (ALIGN_EPI) { if (wr == 0) PG8_BAR; }
        if constexpr (!Epi::AFTER_DRAIN) { E(acc, cur, wr, wc, fr, fq); S.done(cur); }
        if (!has_next) break;
#pragma unroll
        for (int a = 0; a < 2; ++a)
#pragma unroll
            for (int b = 0; b < 2; ++b)
#pragma unroll
                for (int m = 0; m < 4; ++m)
#pragma unroll
                    for (int n = 0; n < 2; ++n) acc[a][b][m][n] = (f32x4){0.f, 0.f, 0.f, 0.f};
        cur = nxt; cA = nA; cB = nB; ++ui;
        if constexpr (ALIGN_EPI) { if (wr == 1) PG8_BAR; }
    }
    PG8_WAIT_V(0);
    if constexpr (!ALIGN_EPI) { if (wr == 0) PG8_BAR; }
    PG8_BAR;
    if constexpr (Epi::AFTER_DRAIN) { E.fused(acc, cur, wr, wc, fr, fq, lds, wid, lane); S.done(cur); }
#undef PG8_SA
#undef PG8_SB
#undef PG8_STAGE
#undef PG8_LDA
#undef PG8_LDB
#undef PG8_MMA
#undef PG8_WAIT_V
#undef PG8_WAIT_L
#undef PG8_BAR
#undef PG8_SCHED
}
}

#ifndef WGM_ALL
#define WGM_ALL 8
#endif
#ifndef WGM_DOWN
#define WGM_DOWN 2
#endif
#ifndef PG8_SP2
#define PG8_SP2 true
#endif
#ifndef PG8_ALIGN
#define PG8_ALIGN true
#endif
constexpr int NWAVES = 8;
constexpr int BATCH = 4, SEQ = 4096, DM = 4096, M = BATCH * SEQ;
constexpr int DFF = 11008, PLE = 256, HD = 128, NH = 16, AW = NH * HD;
constexpr int INC = 6 * AW + 2 * DM;
constexpr int C_QA = 0, C_KA = AW, C_VA = 2 * AW, C_QB = 3 * AW, C_KB = 4 * AW, C_VB = 5 * AW, C_GA = 6 * AW, C_GB = 6 * AW + DM;
constexpr int MB = 256, NBLK = SEQ / MB;
constexpr float RMS_EPS = 1e-6f;
#ifndef MK_N_LAUNCHES
#define MK_N_LAUNCHES 1
#endif
constexpr int N_PHASES = 12;
static_assert(MK_N_LAUNCHES == 1 || MK_N_LAUNCHES == N_PHASES, "MK_N_LAUNCHES is 1 (one launch) or 12 (one launch per phase: debugging)");

constexpr size_t MiB = 1u << 20;
constexpr size_t WS_CTL = 0, CTL_ZERO_BYTES = 512 * 1024;
constexpr size_t WS_KM   = 1 * MiB;
constexpr size_t WS_WGU1 = 2 * MiB;
constexpr size_t WS_WD1  = WS_WGU1 + (size_t)2 * DFF * DM * 2;
constexpr size_t WS_WIN  = WS_WD1 + (size_t)DM * DFF * 2;
constexpr size_t WS_WBR  = WS_WIN + (size_t)INC * DM * 2;
constexpr size_t WS_WOUT = WS_WBR + (size_t)DM * 2 * AW * 2;
constexpr size_t WS_WGU2 = WS_WOUT + (size_t)DM * DM * 2;
constexpr size_t WS_WD2  = WS_WGU2 + (size_t)2 * DFF * DM * 2;
constexpr size_t WS_WPG  = WS_WD2 + (size_t)DM * DFF * 2;
constexpr size_t WS_WPE  = WS_WPG + (size_t)DM * DM * 2;
constexpr size_t WS_PBF  = WS_WPE + (size_t)DM * PLE * 2;
constexpr size_t WS_XBZ  = WS_PBF + (size_t)M * PLE * 2;
constexpr size_t WS_HB   = WS_XBZ + (size_t)M * DM * 2;
constexpr size_t WS_ATT  = WS_HB + (size_t)M * DM * 2;
constexpr size_t WS_R1   = WS_ATT + (size_t)M * DM * 2;
constexpr size_t WS_END  = WS_R1 + (size_t)M * INC * 2;
static_assert(WS_END <= (size_t)1908490240, "d_ws map must fit the guaranteed workspace (sum of the inputs)");
static_assert((WS_WD1 % 256) == 0 && (WS_WIN % 256) == 0 && (WS_XBZ % 256) == 0 && (WS_R1 % 256) == 0, "alignment");
constexpr size_t WS_SS0 = 448 * 1024, WS_SS1 = 256 * 1024, WS_SS2 = 320 * 1024, WS_SS3 = 384 * 1024;
constexpr int CW_TMO = 0, CW_CODE = 1;
constexpr int CW_BG = 12288;
constexpr int CW_QUEUE = 8192;
constexpr int CW_BAR = 4096;

constexpr int RING_OFF = 0, RING_BYTES = 135168;
constexpr int LDSCTL_OFF = RING_BYTES, MISC_OFF = LDSCTL_OFF + 320;
constexpr int LDS_BYTES = 147456;
static_assert(MISC_OFF + 128 <= LDS_BYTES, "LDS map");

#define GAS __attribute__((address_space(1)))
#define LAS __attribute__((address_space(3)))
typedef unsigned short bf16;
typedef unsigned v4u __attribute__((ext_vector_type(4)));
typedef unsigned v2u __attribute__((ext_vector_type(2)));
typedef float f32x4 __attribute__((ext_vector_type(4)));
typedef float f32x16 __attribute__((ext_vector_type(16)));
typedef short bf16x8 __attribute__((ext_vector_type(8)));
typedef short s16x4 __attribute__((ext_vector_type(4)));
typedef GAS unsigned gu32;
#define RLX_AGENT __ATOMIC_RELAXED, __HIP_MEMORY_SCOPE_AGENT
#define LDS_WAIT() asm volatile("s_waitcnt lgkmcnt(0)" ::: "memory")
#define VM_WAIT() asm volatile("s_waitcnt vmcnt(0)" ::: "memory")
#define SBAR() __builtin_amdgcn_sched_barrier(0)
__device__ __forceinline__ unsigned cvtpk(float lo, float hi) { unsigned r; asm volatile("v_cvt_pk_bf16_f32 %0, %1, %2" : "=v"(r) : "v"(lo), "v"(hi)); return r; }
typedef __bf16 bf16x2_t __attribute__((ext_vector_type(2)));
typedef float f32x2_t __attribute__((ext_vector_type(2)));
__device__ __forceinline__ unsigned cvtpk_c(float lo, float hi) { f32x2_t v = {lo, hi}; bf16x2_t b = __builtin_convertvector(v, bf16x2_t); return __builtin_bit_cast(unsigned, b); }

#define XB_TMO      128
#define XB_XCNT(j)  (256  + 64 * (j))
#define XB_XSUB(j)  (1280 + 64 * (j))
#define XB_XGEN(j)  (2304 + 64 * (j))
#define XB_TOP      3328
#define XB_TOPGEN   3392
#define XCD_BAR_WORDS 3456
#define XB_SPIN_CAP (1u << 18)

__device__ __forceinline__ unsigned xb_ld(unsigned* p)              { return __hip_atomic_load(p, __ATOMIC_RELAXED, __HIP_MEMORY_SCOPE_AGENT); }
__device__ __forceinline__ unsigned xb_add(unsigned* p, unsigned v) { return __hip_atomic_fetch_add(p, v, __ATOMIC_RELAXED, __HIP_MEMORY_SCOPE_AGENT); }
__device__ __forceinline__ unsigned xb_xcc_id() { return (unsigned)__builtin_amdgcn_s_getreg((3 << 11) | 20) & 0xFu; }
#define XB_SPIN(cond, bar) do { unsigned _sp = 0; while (cond) { __builtin_amdgcn_s_sleep(1); \
    if ((++_sp & 255u) == 0u) { if (xb_ld(&(bar)[XB_TMO])) break; if (_sp > XB_SPIN_CAP) { atomicAdd(&(bar)[XB_TMO], 1u); break; } } } } while (0)

struct XcdBarrier {
    unsigned* bar; unsigned x;
    volatile LAS unsigned* st;
};

__device__ __forceinline__ XcdBarrier xcd_barrier_post(unsigned* bar, volatile LAS unsigned* st) {
    XcdBarrier b; b.bar = bar; b.x = xb_xcc_id(); b.st = st;
    if (threadIdx.x == 0) (void)xb_add(&bar[XB_XCNT(b.x)], 1u);
    return b;
}
__device__ __forceinline__ void xcd_barrier_complete(unsigned* bar, unsigned x, unsigned& nloc, unsigned& nx) {
    const unsigned G = gridDim.x * gridDim.y * gridDim.z;
    unsigned sum, cnt, mine, sp = 0u;
    for (;;) {
        sum = 0u; cnt = 0u; mine = 0u;
#pragma unroll
        for (unsigned j = 0; j < 16; ++j) { const unsigned c = xb_ld(&bar[XB_XCNT(j)]); sum += c; cnt += (c > 0u) ? 1u : 0u; mine = (j == x) ? c : mine; }
        if (sum == G) break;
        __builtin_amdgcn_s_sleep(1);
        if ((++sp & 255u) == 0u) { if (xb_ld(&bar[XB_TMO])) break; if (sp > XB_SPIN_CAP) { atomicAdd(&bar[XB_TMO], 1u); break; } }
    }
    nloc = mine > 0u ? mine : 1u; nx = cnt > 0u ? cnt : 1u;
}

__device__ __forceinline__ void xcd_barrier(const XcdBarrier& b) {
    asm volatile("s_waitcnt vmcnt(0)" ::: "memory");
    __syncthreads();
    if (threadIdx.x == 0) {
        unsigned* bar = b.bar;
        __builtin_amdgcn_s_waitcnt(0);
        unsigned nloc = b.st[0], nx = b.st[1];
        if (nloc == 0u) { xcd_barrier_complete(bar, b.x, nloc, nx); b.st[0] = nloc; b.st[1] = nx; }
        const unsigned old = xb_add(&bar[XB_XSUB(b.x)], 1u);
        const unsigned gen = old / nloc;
        if (old + 1u == (gen + 1u) * nloc) {
            __builtin_amdgcn_fence(__ATOMIC_RELEASE, "agent");
            asm volatile("s_waitcnt vmcnt(0)" ::: "memory");
            const unsigned og = xb_add(&bar[XB_TOP], 1u);
            const unsigned tg = og / nx;
            if (og + 1u == (tg + 1u) * nx) xb_add(&bar[XB_TOPGEN], 1u);
            else XB_SPIN(xb_ld(&bar[XB_TOPGEN]) == tg, bar);
            __builtin_amdgcn_fence(__ATOMIC_ACQUIRE, "agent");
            xb_add(&bar[XB_XGEN(b.x)], 1u);
            asm volatile("s_waitcnt vmcnt(0)" ::: "memory");
        } else {
            XB_SPIN(xb_ld(&bar[XB_XGEN(b.x)]) == gen, bar);
            __builtin_amdgcn_fence(__ATOMIC_ACQUIRE, "agent");
            asm volatile("s_waitcnt vmcnt(0)" ::: "memory");
        }
    }
    __syncthreads();
}

__device__ __forceinline__ void xcd_barrier_arrive(const XcdBarrier& b, volatile LAS unsigned* mb) {
    asm volatile("s_waitcnt vmcnt(0)" ::: "memory");
    __syncthreads();
    if (threadIdx.x == 0) {
        unsigned* bar = b.bar;
        __builtin_amdgcn_s_waitcnt(0);
        unsigned nloc = b.st[0], nx = b.st[1];
        if (nloc == 0u) { xcd_barrier_complete(bar, b.x, nloc, nx); b.st[0] = nloc; b.st[1] = nx; }
        const unsigned old = xb_add(&bar[XB_XSUB(b.x)], 1u);
        const unsigned gen = old / nloc;
        if (old + 1u == (gen + 1u) * nloc) {
            __builtin_amdgcn_fence(__ATOMIC_RELEASE, "agent");
            asm volatile("s_waitcnt vmcnt(0)" ::: "memory");
            const unsigned og = xb_add(&bar[XB_TOP], 1u);
            const unsigned tg = og / nx;
            if (og + 1u == (tg + 1u) * nx) xb_add(&bar[XB_TOPGEN], 1u);
            else XB_SPIN(xb_ld(&bar[XB_TOPGEN]) == tg, bar);
            __builtin_amdgcn_fence(__ATOMIC_ACQUIRE, "agent");
            xb_add(&bar[XB_XGEN(b.x)], 1u);
            asm volatile("s_waitcnt vmcnt(0)" ::: "memory");
            mb[0] = 0u;
        } else { mb[0] = 1u; mb[1] = gen; }
    }
    asm volatile("s_waitcnt lgkmcnt(0)" ::: "memory"); __syncthreads();
}
__device__ __forceinline__ unsigned xcd_released(const XcdBarrier& b, unsigned gen) { return (xb_ld(&b.bar[XB_XGEN(b.x)]) != gen) ? 1u : 0u; }
__device__ __forceinline__ void xcd_wait_release(const XcdBarrier& b, unsigned gen) { XB_SPIN(xb_ld(&b.bar[XB_XGEN(b.x)]) == gen, b.bar); }
__device__ __forceinline__ void xcd_acquire() { __builtin_amdgcn_fence(__ATOMIC_ACQUIRE, "agent"); asm volatile("s_waitcnt vmcnt(0)" ::: "memory"); }

struct Args { const float* in[19]; float* out; unsigned char* ws; int ph_lo, ph_hi; };
static_assert(sizeof(Args) == 19 * 8 + 8 + 8 + 8, "Args has no padding");

__device__ __forceinline__ float wave_sum(float v) {
#pragma unroll
    for (int o = 1; o < 64; o <<= 1) v += __shfl_xor(v, o);
    return v;
}

template <int DEEP = 0>
__device__ __forceinline__ void tr_item(const float* W, int N, bf16* WT, int ldk, int kofs, int rowbase, LAS float* scr, int kb, int nb, int lane, const float* gain = nullptr) {
    const float* src = W + (size_t)(64 * kb) * N + 64 * nb + lane;
    const int c = lane & 7;
    f32x4 ga = (f32x4){1.f, 1.f, 1.f, 1.f}, gb = ga;
    if (gain) { ga = *(const GAS f32x4*)(gain + 64 * kb + 8 * c); gb = *(const GAS f32x4*)(gain + 64 * kb + 8 * c + 4); }
    if (DEEP) { float v[64];
#pragma unroll
        for (int kk = 0; kk < 64; ++kk) v[kk] = __builtin_nontemporal_load(src + (size_t)kk * N);
#pragma unroll
        for (int kk = 0; kk < 64; ++kk) scr[kk * 65 + lane] = v[kk];
    } else {
#pragma unroll 16
        for (int kk = 0; kk < 64; ++kk) scr[kk * 65 + lane] = __builtin_nontemporal_load(src + (size_t)kk * N);
    }
    LDS_WAIT(); asm volatile("" ::: "memory");
#pragma unroll
    for (int j = 0; j < 8; ++j) { const int n = (lane >> 3) + 8 * j; const LAS float* s = scr + (8 * c) * 65 + n;
        v4u o; o.x = cvtpk_c(s[0 * 65] * ga[0], s[1 * 65] * ga[1]); o.y = cvtpk_c(s[2 * 65] * ga[2], s[3 * 65] * ga[3]); o.z = cvtpk_c(s[4 * 65] * gb[0], s[5 * 65] * gb[1]); o.w = cvtpk_c(s[6 * 65] * gb[2], s[7 * 65] * gb[3]);
        if (DEEP) __builtin_nontemporal_store(o, (GAS v4u*)(WT + (size_t)(rowbase + n) * ldk + kofs + 64 * kb + 8 * c)); else *(GAS v4u*)(WT + (size_t)(rowbase + n) * ldk + kofs + 64 * kb + 8 * c) = o; }
    LDS_WAIT(); asm volatile("" ::: "memory");
}
__device__ __forceinline__ void cvt_row_bf16(const float* xrow, bf16* orow, float* ss, int lane) {
    const GAS f32x4* xr = (const GAS f32x4*)xrow + lane;
    f32x4 v[16]; float s = 0.f;
#pragma unroll
    for (int j = 0; j < 16; ++j) { v[j] = __builtin_nontemporal_load(xr + 64 * j); s += (v[j].x * v[j].x + v[j].y * v[j].y) + (v[j].z * v[j].z + v[j].w * v[j].w); }
    s = wave_sum(s);
    GAS v2u* o8 = (GAS v2u*)orow + lane;
#pragma unroll
    for (int j = 0; j < 16; ++j) { v2u w; w.x = cvtpk(v[j].x, v[j].y); w.y = cvtpk(v[j].z, v[j].w); o8[64 * j] = w; }
    if (lane == 0) *ss = s;
}
__device__ __forceinline__ void rms_row_out(const bf16* hrow, float* orow, const float* gain, int lane) {
    const GAS v4u* hr = (const GAS v4u*)hrow + lane; const GAS f32x4* gr = (const GAS f32x4*)gain; GAS f32x4* o4 = (GAS f32x4*)orow;
    v4u w[8]; float s = 0.f;
#pragma unroll
    for (int j = 0; j < 8; ++j) { w[j] = hr[64 * j];
        const float a0 = __uint_as_float(w[j].x << 16), a1 = __uint_as_float(w[j].x & 0xffff0000u), a2 = __uint_as_float(w[j].y << 16), a3 = __uint_as_float(w[j].y & 0xffff0000u);
        const float a4 = __uint_as_float(w[j].z << 16), a5 = __uint_as_float(w[j].z & 0xffff0000u), a6 = __uint_as_float(w[j].w << 16), a7 = __uint_as_float(w[j].w & 0xffff0000u);
        s += (a0 * a0 + a1 * a1) + (a2 * a2 + a3 * a3) + (a4 * a4 + a5 * a5) + (a6 * a6 + a7 * a7); }
    const float rstd = 1.0f / sqrtf(wave_sum(s) * (1.f / DM) + RMS_EPS);
#pragma unroll
    for (int j = 0; j < 8; ++j) { const int e = (64 * j + lane) * 2;
        const f32x4 g0 = gr[e], g1 = gr[e + 1]; f32x4 o0, o1;
        o0[0] = __uint_as_float(w[j].x << 16) * rstd * g0[0]; o0[1] = __uint_as_float(w[j].x & 0xffff0000u) * rstd * g0[1]; o0[2] = __uint_as_float(w[j].y << 16) * rstd * g0[2]; o0[3] = __uint_as_float(w[j].y & 0xffff0000u) * rstd * g0[3];
        o1[0] = __uint_as_float(w[j].z << 16) * rstd * g1[0]; o1[1] = __uint_as_float(w[j].z & 0xffff0000u) * rstd * g1[1]; o1[2] = __uint_as_float(w[j].w << 16) * rstd * g1[2]; o1[3] = __uint_as_float(w[j].w & 0xffff0000u) * rstd * g1[3];
        o4[e] = o0; o4[e + 1] = o1; }
}

namespace att {
constexpr int LD = 2 * HD, LDO = DM;
constexpr int SHM_V = 16384, SHM_K = 16384;
constexpr int NSLOT = 3, OFF_V = 0, OFF_K = NSLOT * SHM_V, OFF_WS = NSLOT * (SHM_V + SHM_K), OFF_FLAG = OFF_WS + NWAVES * 256, OFF_KMS = OFF_FLAG + 64;
#define KSWZ(row, colB) ((row) * 256 + ((colB) ^ (((row) & 7) << 4)))
__device__ __forceinline__ int v_st(int k, int c) { const int kk = (k & ~0xC) | ((k & 4) << 1) | ((k & 8) >> 1); return ((kk >> 3) * 4 + (c >> 5)) * 512 + ((kk & 7) * 32 + (c & 31)) * 2; }
__device__ __forceinline__ int v_rd_base(int lane) { return ((lane & 3) << 3) | (((lane >> 2) & 3) << 6) | (((lane >> 4) & 1) << 5) | (((lane >> 5) & 1) << 8); }
constexpr int v_rd_off(int d0, int ks, int half) { return d0 * 512 + ks * 4096 + half * 2048; }
__device__ __forceinline__ int crow(int r, int hi) { return (r & 3) + 8 * (r >> 2) + 4 * hi; }
__device__ __forceinline__ float pmaxswap(float v) { auto rr = __builtin_amdgcn_permlane32_swap(__float_as_uint(v), __float_as_uint(v), false, false); return fmaxf(__uint_as_float(rr[0]), __uint_as_float(rr[1])); }
__device__ __forceinline__ float psumswap(float v) { auto rr = __builtin_amdgcn_permlane32_swap(__float_as_uint(v), __float_as_uint(v), false, false); return __uint_as_float(rr[0]) + __uint_as_float(rr[1]); }

__device__ __forceinline__ void qkt(f32x16& p0, f32x16& p1, LAS const char* Kbuf, int r32, int hi, const bf16x8* qr) {
    p0 = f32x16{}; p1 = f32x16{};
    LAS const char* kb[4];
#pragma unroll
    for (int dd = 0; dd < 4; ++dd) kb[dd] = Kbuf + KSWZ(r32, (dd * 16 + hi * 8) * 2);
#pragma unroll
    for (int d0 = 0; d0 < 8; ++d0) { LAS const char* a = kb[d0 & 3] + (d0 >> 2) * 128;
        const bf16x8 b0 = *(LAS const bf16x8*)a; const bf16x8 b1 = *(LAS const bf16x8*)(a + 32 * 256);
        p0 = __builtin_amdgcn_mfma_f32_32x32x16_bf16(b0, qr[d0], p0, 0, 0, 0);
        p1 = __builtin_amdgcn_mfma_f32_32x32x16_bf16(b1, qr[d0], p1, 0, 0, 0); }
}
__device__ __forceinline__ void pv_tile(f32x16* o, int vb, bf16x8 pa0, bf16x8 pa1, bf16x8 pa2, bf16x8 pa3) {
#define TRRD(dst, off) asm volatile("ds_read_b64_tr_b16 %0, %1 offset:%2" : "=&v"(dst) : "v"(vb), "i"(off) : "memory")
#define PV_RD(S, d0) do { constexpr int b_ = v_rd_off(d0, 0, 0); \
        TRRD(S##l0, b_); TRRD(S##h0, b_ + 2048); TRRD(S##l1, b_ + 4096); TRRD(S##h1, b_ + 6144); TRRD(S##l2, b_ + 8192); TRRD(S##h2, b_ + 10240); TRRD(S##l3, b_ + 12288); TRRD(S##h3, b_ + 14336); } while (0)
#define PV_MM(S, d0) do { \
        o[d0] = __builtin_amdgcn_mfma_f32_32x32x16_bf16(pa0, (bf16x8){S##l0[0], S##l0[1], S##l0[2], S##l0[3], S##h0[0], S##h0[1], S##h0[2], S##h0[3]}, o[d0], 0, 0, 0); \
        o[d0] = __builtin_amdgcn_mfma_f32_32x32x16_bf16(pa1, (bf16x8){S##l1[0], S##l1[1], S##l1[2], S##l1[3], S##h1[0], S##h1[1], S##h1[2], S##h1[3]}, o[d0], 0, 0, 0); \
        o[d0] = __builtin_amdgcn_mfma_f32_32x32x16_bf16(pa2, (bf16x8){S##l2[0], S##l2[1], S##l2[2], S##l2[3], S##h2[0], S##h2[1], S##h2[2], S##h2[3]}, o[d0], 0, 0, 0); \
        o[d0] = __builtin_amdgcn_mfma_f32_32x32x16_bf16(pa3, (bf16x8){S##l3[0], S##l3[1], S##l3[2], S##l3[3], S##h3[0], S##h3[1], S##h3[2], S##h3[3]}, o[d0], 0, 0, 0); } while (0)
    s16x4 Al0, Al1, Al2, Al3, Ah0, Ah1, Ah2, Ah3, Bl0, Bl1, Bl2, Bl3, Bh0, Bh1, Bh2, Bh3;
    PV_RD(A, 0);
    PV_RD(B, 1); asm volatile("s_waitcnt lgkmcnt(8)" ::: "memory"); SBAR(); PV_MM(A, 0); SBAR();
    PV_RD(A, 2); asm volatile("s_waitcnt lgkmcnt(8)" ::: "memory"); SBAR(); PV_MM(B, 1); SBAR();
    PV_RD(B, 3); asm volatile("s_waitcnt lgkmcnt(8)" ::: "memory"); SBAR(); PV_MM(A, 2); SBAR();
    asm volatile("s_waitcnt lgkmcnt(0)" ::: "memory"); SBAR(); PV_MM(B, 3);
#undef PV_MM
#undef PV_RD
#undef TRRD
}
__device__ __forceinline__ void pack_p(const f32x16& p0, const f32x16& p1, bf16x8& pa0, bf16x8& pa1, bf16x8& pa2, bf16x8& pa3) {
#define PK4(P, B_, OUT) do { unsigned a0 = cvtpk(P[B_+0], P[B_+1]), a1 = cvtpk(P[B_+2], P[B_+3]); \
        unsigned b0 = cvtpk(P[B_+4], P[B_+5]), b1 = cvtpk(P[B_+6], P[B_+7]); \
        auto r0 = __builtin_amdgcn_permlane32_swap(a0, b0, false, false); auto r1 = __builtin_amdgcn_permlane32_swap(a1, b1, false, false); \
        v4u w = {r0[0], r1[0], r0[1], r1[1]}; OUT = *reinterpret_cast<bf16x8*>(&w); } while (0)
    PK4(p0, 0, pa0); PK4(p0, 8, pa1); PK4(p1, 0, pa2); PK4(p1, 8, pa3);
#undef PK4
}

template <int MODE>
__device__ __forceinline__ void attn_unit(const bf16* Qg, const bf16* Kg, const bf16* Vg, bf16* Og, int qb, float slope, const float* KMg, const float* KNg, LAS char* lds) {
    const int tid = threadIdx.x, wid = __builtin_amdgcn_readfirstlane(tid >> 6), lane = tid & 63, r32 = lane & 31, hi = lane >> 5;
    const int t0 = qb * 256 + wid * 32, trow = t0 + r32;
    LAS float* wsf = (LAS float*)(lds + OFF_WS) + wid * 64; LAS float* li_l = wsf;
    volatile LAS int* flags = (volatile LAS int*)(lds + OFF_FLAG);
    const int vb0 = (int)(size_t)(lds + OFF_V) + v_rd_base(lane);
    constexpr float LOG2E = 1.4426950408889634f, SCALE = 0.08838834764831845f, C2 = LOG2E * SCALE;
    bf16x8 qr[8];
#pragma unroll
    for (int d0 = 0; d0 < 8; ++d0) qr[d0] = *(const GAS bf16x8*)(Qg + (size_t)trow * LD + d0 * 16 + hi * 8);
    unsigned selmask = 0u;
    if (MODE == 0) {
        if (qb <= 3) selmask = (1u << qb) - 1u;
        else {
            const int nrow = (r32 & 3) + 4 * (r32 >> 3);
            f32x16 g = f32x16{};
#pragma unroll
            for (int d0 = 0; d0 < 8; ++d0) {
                f32x4 a = (f32x4){0.f, 0.f, 0.f, 0.f}, b = a;
                if (nrow < qb) { const GAS f32x4* kp = (const GAS f32x4*)(KMg + nrow * HD + d0 * 16 + hi * 8); a = kp[0]; b = kp[1]; }
                v4u whi, wlo;
                whi.x = cvtpk(a[0], a[1]); whi.y = cvtpk(a[2], a[3]); whi.z = cvtpk(b[0], b[1]); whi.w = cvtpk(b[2], b[3]);
                wlo.x = cvtpk(a[0] - __uint_as_float(whi.x << 16), a[1] - __uint_as_float(whi.x & 0xffff0000u)); wlo.y = cvtpk(a[2] - __uint_as_float(whi.y << 16), a[3] - __uint_as_float(whi.y & 0xffff0000u));
                wlo.z = cvtpk(b[0] - __uint_as_float(whi.z << 16), b[1] - __uint_as_float(whi.z & 0xffff0000u)); wlo.w = cvtpk(b[2] - __uint_as_float(whi.w << 16), b[3] - __uint_as_float(whi.w & 0xffff0000u));
                g = __builtin_amdgcn_mfma_f32_32x32x16_bf16(*reinterpret_cast<bf16x8*>(&whi), qr[d0], g, 0, 0, 0);
                g = __builtin_amdgcn_mfma_f32_32x32x16_bf16(*reinterpret_cast<bf16x8*>(&wlo), qr[d0], g, 0, 0, 0);
            }
#pragma unroll
            for (int pick = 0; pick < 3; ++pick) { float best = -__builtin_inff(); int bi = -1;
#pragma unroll
                for (int n = 0; n < 16; ++n) { const bool cand = (n < qb) && !((selmask >> n) & 1u); if (cand && (bi < 0 || g[n] > best)) { best = g[n]; bi = n; } }
                if (bi >= 0) selmask |= 1u << bi; }
        }
    }
    const float sl2 = slope * LOG2E;
    float mrow = 0.f, mrow_w = 0.f;
    if (MODE == 0) {
        float qn = 0.f;
#pragma unroll
        for (int d0 = 0; d0 < 8; ++d0)
#pragma unroll
            for (int j = 0; j < 8; ++j) { const float v = __uint_as_float(((unsigned)(unsigned short)qr[d0][j]) << 16); qn += v * v; }
        qn = psumswap(qn);
        float kn = 0.f;
        for (int n = 0; n <= qb; ++n) kn = fmaxf(kn, KNg[n]);
        mrow = C2 * sqrtf(qn) * sqrtf(kn) * 1.001f;
        mrow_w = mrow;
#pragma unroll
        for (int o_ = 1; o_ < 64; o_ <<= 1) mrow_w = fmaxf(mrow_w, __shfl_xor(mrow_w, o_));
    }
    float l_reg = 0.f, carry = 0.f; f32x16 o[4] = {};
    bool done = false;
    const int NT = 4 * (qb + 1);
    int gofK[2], gofV[2];
#pragma unroll
    for (int i = 0; i < 2; ++i) { const int pi = wid * 2 + i;
        { const int row = pi * 4 + (lane >> 4), colB = (16 * (lane & 15)) ^ ((row & 7) << 4); gofK[i] = row * LD + (colB >> 1); }
        { const int sub = 2 * pi + (lane >> 5), kk = (sub >> 2) * 8 + ((lane & 31) >> 2), c = (sub & 3) * 32 + 8 * (lane & 3), k = (kk & ~0xC) | ((kk & 4) << 1) | ((kk & 8) >> 1); gofV[i] = k * LD + c; } }
#define TDMA(jt_) do { const int sl_ = (jt_) % NSLOT; const bf16* kt_ = Kg + (size_t)(jt_) * 64 * LD; const bf16* vt_ = Vg + (size_t)(jt_) * 64 * LD; \
        _Pragma("unroll") for (int i_ = 0; i_ < 2; ++i_) { \
            __builtin_amdgcn_global_load_lds((const unsigned*)(kt_ + gofK[i_]), (LAS unsigned*)(lds + OFF_K + sl_ * SHM_K + (wid * 2 + i_) * 1024), 16, 0, 0); \
            __builtin_amdgcn_global_load_lds((const unsigned*)(vt_ + gofV[i_]), (LAS unsigned*)(lds + OFF_V + sl_ * SHM_V + (wid * 2 + i_) * 1024), 16, 0, 0); } } while (0)
    TDMA(NT - 1); TDMA(NT - 2);
    asm volatile("s_waitcnt vmcnt(4)" ::: "memory");
    __builtin_amdgcn_s_barrier(); asm volatile("" ::: "memory");
    for (int jt = NT - 1; jt >= 0; --jt) {
        const int buf = jt % NSLOT;
        if (jt >= 2) TDMA(jt - 2);
        const int kb = jt * 64;
        bool act = (kb <= t0 + 31) && !done;
        const int nblk = jt >> 2;
        if (MODE == 0 && nblk < qb) act = act && __any((selmask >> nblk) & 1u);
        if (act) {
            f32x16 p0, p1;
            qkt(p0, p1, (LAS const char*)(lds + OFF_K + buf * SHM_K), r32, hi, qr);
            const int dq = trow - kb - 4 * hi;
            if (MODE == 0) {
                const bool sel = (nblk >= qb) || ((selmask >> nblk) & 1u);
                const float A0 = sel ? (-sl2 * (float)dq - mrow) : -__builtin_inff();
#pragma unroll
                for (int r = 0; r < 16; ++r) { const int c = (r & 3) + 8 * (r >> 2); const float B = A0 + sl2 * (float)c; p0[r] = fmaf(p0[r], C2, B); p1[r] = fmaf(p1[r], C2, B + 32.f * sl2); }
                if (kb + 63 > t0) {
#pragma unroll
                    for (int r = 0; r < 16; ++r) { const int c = (r & 3) + 8 * (r >> 2); if (c > dq) p0[r] = -__builtin_inff(); if (c + 32 > dq) p1[r] = -__builtin_inff(); }
                }
                float ps = 0.f;
#pragma unroll
                for (int r = 0; r < 16; ++r) { p0[r] = __builtin_amdgcn_exp2f(p0[r]); ps += p0[r]; }
#pragma unroll
                for (int r = 0; r < 16; ++r) { p1[r] = __builtin_amdgcn_exp2f(p1[r]); ps += p1[r]; }
                l_reg += psumswap(ps);
            } else {
                f32x16 k0, k1;
#pragma unroll
                for (int r = 0; r < 16; ++r) { const int c = (r & 3) + 8 * (r >> 2);
                    { const float z2 = p0[r] * C2; const float sp = fmaxf(z2, 0.f) + __builtin_amdgcn_logf(1.0f + __builtin_amdgcn_exp2f(-fabsf(z2))); const bool v = c < dq; k0[r] = v ? -sp : 0.f; p0[r] = v ? z2 - sp : -__builtin_inff(); }
                    { const float z2 = p1[r] * C2; const float sp = fmaxf(z2, 0.f) + __builtin_amdgcn_logf(1.0f + __builtin_amdgcn_exp2f(-fabsf(z2))); const bool v = c + 32 < dq; k1[r] = v ? -sp : 0.f; p1[r] = v ? z2 - sp : -__builtin_inff(); } }
                float T0[4], T1[4];
#pragma unroll
                for (int g = 0; g < 4; ++g) {
                    { const float a3 = k0[4 * g + 3], a2 = k0[4 * g + 2], a1 = k0[4 * g + 1], a0 = k0[4 * g]; const float e2 = a3, e1 = e2 + a2, e0 = e1 + a1; T0[g] = e0 + a0; k0[4 * g + 3] = 0.f; k0[4 * g + 2] = e2; k0[4 * g + 1] = e1; k0[4 * g] = e0; }
                    { const float a3 = k1[4 * g + 3], a2 = k1[4 * g + 2], a1 = k1[4 * g + 1], a0 = k1[4 * g]; const float e2 = a3, e1 = e2 + a2, e0 = e1 + a1; T1[g] = e0 + a0; k1[4 * g + 3] = 0.f; k1[4 * g + 2] = e2; k1[4 * g + 1] = e1; k1[4 * g] = e0; }
                }
                float P0[4], P1[4];
#pragma unroll
                for (int g = 0; g < 4; ++g) { P0[g] = __shfl_xor(T0[g], 32); P1[g] = __shfl_xor(T1[g], 32); }
                float R1[4], R0[4];
                R1[3] = 0.f; R1[2] = T1[3] + P1[3]; R1[1] = R1[2] + (T1[2] + P1[2]); R1[0] = R1[1] + (T1[1] + P1[1]); const float tot1 = R1[0] + (T1[0] + P1[0]);
                R0[3] = 0.f; R0[2] = T0[3] + P0[3]; R0[1] = R0[2] + (T0[2] + P0[2]); R0[0] = R0[1] + (T0[1] + P0[1]); const float tot0 = R0[0] + (T0[0] + P0[0]);
#pragma unroll
                for (int g = 0; g < 4; ++g) {
                    const float off1 = carry + R1[g] + (hi == 0 ? P1[g] : 0.f), off0 = carry + tot1 + R0[g] + (hi == 0 ? P0[g] : 0.f);
#pragma unroll
                    for (int i = 0; i < 4; ++i) { p0[4 * g + i] = __builtin_amdgcn_exp2f(p0[4 * g + i] + k0[4 * g + i] + off0); p1[4 * g + i] = __builtin_amdgcn_exp2f(p1[4 * g + i] + k1[4 * g + i] + off1); }
                }
                carry += tot0 + tot1;
                if (__all(carry < -150.1f)) done = true;
            }
            bf16x8 pa0, pa1, pa2, pa3;
            pack_p(p0, p1, pa0, pa1, pa2, pa3);
            pv_tile(o, vb0 + buf * SHM_V, pa0, pa1, pa2, pa3);
        }
        bool stop = false;
        if (MODE == 0 && jt >= 1 && 2.f * mrow_w - sl2 * (float)(t0 - (jt - 1) * 64 - 63) < -150.5f) done = true;
        if (lane == 0) flags[(jt & 1) * 8 + wid] = done ? 1 : 0;
        if (jt >= 2) asm volatile("s_waitcnt vmcnt(4) lgkmcnt(0)" ::: "memory"); else asm volatile("s_waitcnt vmcnt(0) lgkmcnt(0)" ::: "memory");
        __builtin_amdgcn_s_barrier(); asm volatile("" ::: "memory");
        { int all = 1;
#pragma unroll
            for (int w = 0; w < 8; ++w) all &= flags[(jt & 1) * 8 + w];
            stop = (all != 0); }
        if (stop) break;
    }
    asm volatile("s_waitcnt vmcnt(0)" ::: "memory");
#undef TDMA
    float rli[16];
    if (MODE == 0) { if (hi == 0) li_l[r32] = l_reg; LDS_WAIT();
#pragma unroll
        for (int r = 0; r < 16; ++r) rli[r] = __builtin_amdgcn_rcpf(li_l[crow(r, hi)]); }
    bf16* Ow = Og + (size_t)t0 * LDO;
#pragma unroll
    for (int r = 0; r < 16; ++r) { const int orow = crow(r, hi);
#pragma unroll
        for (int d0 = 0; d0 < 4; ++d0) { const float v = (MODE == 0) ? o[d0][r] * rli[r] : o[d0][r];
            *(GAS unsigned short*)(Ow + (size_t)orow * LDO + d0 * 32 + r32) = (unsigned short)cvtpk_c(v, v); } }
    LDS_WAIT();
    __syncthreads();
}
}

__global__ void __launch_bounds__(NWAVES * 64, 2) mega_fwd(Args args) {
    extern __shared__ __attribute__((aligned(16))) unsigned char lds_raw[];
    LAS unsigned char* lds = (LAS unsigned char*)lds_raw;
    volatile LAS unsigned* MISC = (volatile LAS unsigned*)(lds + MISC_OFF);
    const int tid = threadIdx.x, lane = tid & 63, wave = __builtin_amdgcn_readfirstlane(tid >> 6);
    const int G = gridDim.x, bid = blockIdx.x;
    unsigned char* ws = args.ws;
    gu32* ctl = (gu32*)(ws + WS_CTL);
    const float* x = args.in[0]; const float* pin = args.in[1];
    const float* g_ffn1 = args.in[2]; const float* w_g1 = args.in[3]; const float* w_u1 = args.in[4]; const float* w_d1 = args.in[5];
    const float* g_mix = args.in[6]; const float* w_in = args.in[7]; const float* w_bA = args.in[8]; const float* w_bB = args.in[9]; const float* w_out = args.in[10];
    const float* g_ffn2 = args.in[11]; const float* w_g2 = args.in[12]; const float* w_u2 = args.in[13]; const float* w_d2 = args.in[14];
    const float* g_ple = args.in[15]; const float* w_pg = args.in[16]; const float* w_pe = args.in[17]; const float* g_fin = args.in[18];
    float* out = args.out;
    bf16* WGU1 = (bf16*)(ws + WS_WGU1); bf16* WD1 = (bf16*)(ws + WS_WD1); bf16* WIN = (bf16*)(ws + WS_WIN); bf16* WBR = (bf16*)(ws + WS_WBR); bf16* WOUT = (bf16*)(ws + WS_WOUT);
    bf16* WGU2 = (bf16*)(ws + WS_WGU2); bf16* WD2 = (bf16*)(ws + WS_WD2); bf16* WPG = (bf16*)(ws + WS_WPG); bf16* WPE = (bf16*)(ws + WS_WPE);
    bf16* PBF = (bf16*)(ws + WS_PBF); bf16* XB = (bf16*)(ws + WS_XBZ); bf16* Z = XB; bf16* HF = XB;     bf16* HB = (bf16*)(ws + WS_HB); bf16* ATT = (bf16*)(ws + WS_ATT); bf16* PE = (bf16*)args.out;
    bf16* QKV = (bf16*)(ws + WS_R1); bf16* GAB = QKV + (size_t)6 * M * AW; bf16* ACT = (bf16*)(ws + WS_R1);
    float* SS0 = (float*)(ws + WS_SS0); float* SS1 = (float*)(ws + WS_SS1); float* SS2 = (float*)(ws + WS_SS2); float* SS3 = (float*)(ws + WS_SS3);
    float* KM = (float*)(ws + WS_KM); float* KN = (float*)(ws + WS_KM + 512 * 1024);

    for (int u = tid; u < (LDS_BYTES - LDSCTL_OFF) / 4; u += NWAVES * 64) ((LAS unsigned*)(lds + LDSCTL_OFF))[u] = 0u;
    __syncthreads();
    XcdBarrier bar; bar.bar = (unsigned*)(ctl + CW_BAR); bar.x = 0; bar.st = nullptr;
    if (MK_N_LAUNCHES == 1) bar = xcd_barrier_post((unsigned*)(ctl + CW_BAR), MISC + 8);
    const int lo = args.ph_lo, hi = args.ph_hi;
#define IN(k) (lo <= (k) && (k) < hi)
#define SEAM(k) do { if (IN(k) && IN((k) + 1)) xcd_barrier(bar); } while (0)
    const int gw = bid * NWAVES + wave, NGW = G * NWAVES;
    LAS float* rsl = (LAS float*)(lds + LDSCTL_OFF + 1024);
#define PREP_RS(RSV, SSp, S_) pg8::RowScale RSV{SSp, rsl, -1}; do { pg8::Unit u0_; if (S_.next(0, u0_)) { RSV.pm0 = u0_.pm; if (tid < 256) rsl[tid] = __builtin_amdgcn_rsqf(SSp[u0_.pm * 256 + tid] * (1.0f / DM) + RMS_EPS); } LDS_WAIT(); __syncthreads(); } while (0)

    constexpr int I_GU = (DM / 64) * (DFF / 64), I_D = (DFF / 64) * (DM / 64), I_IN = (DM / 64) * (INC / 64), I_BR = (AW / 64) * (DM / 64), I_SQ = (DM / 64) * (DM / 64), I_PE = (PLE / 64) * (DM / 64);
    constexpr int NITEMS = 4 * I_GU + 2 * I_D + I_IN + 2 * I_BR + 2 * I_SQ + I_PE;
    const bool tailfill = (G == 256);
#define CONV_ITEM(it_) do { int r = (it_); LAS float* scr = (LAS float*)(lds + RING_OFF + wave * 16640);     \
        if (r < 4 * I_GU) { const int which = r / I_GU; r -= which * I_GU; const int nbn = DFF / 64, kb = r / nbn, nb = r % nbn; const int n0 = 64 * nb;     \
            const float* W = which == 0 ? w_g1 : which == 1 ? w_u1 : which == 2 ? w_g2 : w_u2; bf16* WT = which < 2 ? WGU1 : WGU2; \
            tr_item(W, DFF, WT, DM, 0, (n0 >> 7) * 256 + (n0 & 127) + (which & 1) * 128, scr, kb, nb, lane, which < 2 ? g_ffn1 : g_ffn2); break; } \
        r -= 4 * I_GU; \
        if (r < 2 * I_D) { const int which = r / I_D; r -= which * I_D; const int nbn = DM / 64, kb = r / nbn, nb = r % nbn; \
            tr_item(which ? w_d2 : w_d1, DM, which ? WD2 : WD1, DFF, 0, 64 * nb, scr, kb, nb, lane); break; } \
        r -= 2 * I_D; \
        if (r < I_IN) { const int nbn = INC / 64, kb = r / nbn, nb = r % nbn; tr_item(w_in, INC, WIN, DM, 0, 64 * nb, scr, kb, nb, lane, g_mix); break; } \
        r -= I_IN; \
        if (r < 2 * I_BR) { const int which = r / I_BR; r -= which * I_BR; const int nbn = DM / 64, kb = r / nbn, nb = r % nbn; \
            tr_item(which ? w_bB : w_bA, DM, WBR, 2 * AW, which * AW, 64 * nb, scr, kb, nb, lane); break; } \
        r -= 2 * I_BR; \
        if (r < 2 * I_SQ) { const int which = r / I_SQ; r -= which * I_SQ; const int nbn = DM / 64, kb = r / nbn, nb = r % nbn; \
            tr_item(which ? w_pg : w_out, DM, which ? WPG : WOUT, DM, 0, 64 * nb, scr, kb, nb, lane, which ? g_ple : nullptr); break; } \
        r -= 2 * I_SQ; \
        { const int nbn = DM / 64, kb = r / nbn, nb = r % nbn; tr_item(w_pe, DM, WPE, PLE, 0, 64 * nb, scr, kb, nb, lane); } } while (0)
    constexpr int N_LATE = I_D + I_IN + 2 * I_BR + I_SQ + 2 * I_GU + I_D + I_SQ, NT_BG = N_LATE / 8, N_EARLY = NITEMS - N_LATE;
    constexpr int T_D1 = I_D / 8, T_IN = T_D1 + I_IN / 8, T_BR = T_IN + 2 * I_BR / 8, T_OUT = T_BR + I_SQ / 8;
    static_assert(N_LATE % 8 == 0 && I_D % 8 == 0 && I_IN % 8 == 0 && (2 * I_BR) % 8 == 0 && I_SQ % 8 == 0, "tickets of 8 tiles, groups on ticket boundaries");
#define BG_CONV(j_) do { int q = (j_); LAS float* scr = (LAS float*)(lds + RING_OFF + wave * 16640); \
        const float* W_; int N_; bf16* WT_; int ldk_, kofs_ = 0, rowbase_, kb_, nb_; const float* gain_ = nullptr; \
        if (q < I_D) { const int nbn = DM / 64; kb_ = q / nbn; nb_ = q % nbn; W_ = w_d1; N_ = DM; WT_ = WD1; ldk_ = DFF; rowbase_ = 64 * nb_; } \
        else if ((q -= I_D) < I_IN) { const int nbn = INC / 64; kb_ = q / nbn; nb_ = q % nbn; W_ = w_in; N_ = INC; WT_ = WIN; ldk_ = DM; rowbase_ = 64 * nb_; gain_ = g_mix; } \
        else if ((q -= I_IN) < 2 * I_BR) { const int which = q / I_BR; q -= which * I_BR; const int nbn = DM / 64; kb_ = q / nbn; nb_ = q % nbn; W_ = which ? w_bB : w_bA; N_ = DM; WT_ = WBR; ldk_ = 2 * AW; kofs_ = which * AW; rowbase_ = 64 * nb_; } \
        else if ((q -= 2 * I_BR) < I_SQ) { const int nbn = DM / 64; kb_ = q / nbn; nb_ = q % nbn; W_ = w_out; N_ = DM; WT_ = WOUT; ldk_ = DM; rowbase_ = 64 * nb_; } \
        else if ((q -= I_SQ) < 2 * I_GU) { const int which = 2 + q / I_GU; q -= (which - 2) * I_GU; const int nbn = DFF / 64; kb_ = q / nbn; nb_ = q % nbn; const int n0 = 64 * nb_;     \
            W_ = which == 2 ? w_g2 : w_u2; N_ = DFF; WT_ = WGU2; ldk_ = DM; rowbase_ = (n0 >> 7) * 256 + (n0 & 127) + (which & 1) * 128; gain_ = g_ffn2; } \
        else if ((q -= 2 * I_GU) < I_D) { const int nbn = DM / 64; kb_ = q / nbn; nb_ = q % nbn; W_ = w_d2; N_ = DM; WT_ = WD2; ldk_ = DFF; rowbase_ = 64 * nb_; } \
        else { q -= I_D; const int nbn = DM / 64; kb_ = q / nbn; nb_ = q % nbn; W_ = w_pg; N_ = DM; WT_ = WPG; ldk_ = DM; rowbase_ = 64 * nb_; gain_ = g_ple; } \
        tr_item<1>(W_, N_, WT_, ldk_, kofs_, rowbase_, scr, kb_, nb_, lane, gain_); } while (0)
#define TRY_BG(more_) do { if (tid == 0) MISC[17] = __hip_atomic_fetch_add(ctl + CW_BG, 1u, RLX_AGENT);     \
        LDS_WAIT(); __syncthreads(); const unsigned t_ = MISC[17]; __syncthreads(); \
        more_ = t_ < (unsigned)NT_BG; if (more_) BG_CONV((int)t_ * 8 + wave); } while (0)
#define DRAIN_BG(T_) do { for (;;) { if (tid == 0) { const unsigned c_ = __hip_atomic_load(ctl + CW_BG, RLX_AGENT); MISC[17] = (c_ >= (unsigned)(T_)) ? 0xffffffffu : __hip_atomic_fetch_add(ctl + CW_BG, 1u, RLX_AGENT); } \
        LDS_WAIT(); __syncthreads(); const unsigned t_ = MISC[17]; __syncthreads(); if (t_ >= (unsigned)NT_BG) break; BG_CONV((int)t_ * 8 + wave); if (t_ >= (unsigned)(T_)) break; } } while (0)
#define SEAM_BG(k) do { if (IN(k) && IN((k) + 1)) { if (MK_N_LAUNCHES != 1) { xcd_barrier(bar); break; } \
        xcd_barrier_arrive(bar, MISC + 18); \
        if (MISC[18] != 0u) { const unsigned gen_ = MISC[19]; \
            for (;;) { if (tid == 0) MISC[20] = xcd_released(bar, gen_); LDS_WAIT(); __syncthreads(); const unsigned rel_ = MISC[20]; __syncthreads(); if (rel_) break; \
                bool more_; TRY_BG(more_); if (!more_) { if (tid == 0) xcd_wait_release(bar, gen_); break; } } \
            if (tid == 0) xcd_acquire(); } \
        __syncthreads(); } } while (0)
    if (IN(0)) {
#pragma unroll 1
        for (int it = gw; it < N_EARLY; it += NGW) { int e = N_EARLY - 1 - it, ridx;
            if (e < 2 * I_GU) ridx = e; else ridx = 4 * I_GU + 2 * I_D + I_IN + 2 * I_BR + 2 * I_SQ + (e - 2 * I_GU);
            CONV_ITEM(ridx); }
        for (int m = gw; m < M; m += NGW) cvt_row_bf16(x + (size_t)m * DM, XB + (size_t)m * DM, SS0 + m, lane);
        for (int i = bid * 512 + tid; i < M * PLE / 8; i += G * 512) { const GAS f32x4* s = (const GAS f32x4*)pin + 2 * (size_t)i; const f32x4 a = s[0], b = s[1];
            v4u w; w.x = cvtpk(a.x, a.y); w.y = cvtpk(a.z, a.w); w.z = cvtpk(b.x, b.y); w.w = cvtpk(b.z, b.w); ((GAS v4u*)PBF)[i] = w; }
    }
    SEAM(0);
    if (IN(1)) {
        pg8::Gemm g{XB, WGU1, M, 2 * DFF, DM, DM, DM}; pg8::StaticOrder S; S.init(M, 2 * DFF, G, bid, WGM_ALL);
        PREP_RS(RS, SS0, S); pg8::EpiSwiGLU E{ACT, DFF, RS};
        pg8::gemm_phase<pg8::EpiSwiGLU, pg8::StaticOrder, PG8_ALIGN, PG8_SP2>(lds + RING_OFF, g, S, E);
        if (tailfill && bid >= 128) {
            pg8::Gemm gp{PBF, WPE, M, DM, PLE, PLE, PLE}; pg8::StaticOrder Sp; Sp.init(M, DM, 128, bid - 128, WGM_ALL); Sp.Lend = 512;
            pg8::EpiBf16 Ep{PE, DM, pg8::RowScale{nullptr, rsl, -1}, 256, 1 << 30, nullptr, 0};
            pg8::gemm_phase<pg8::EpiBf16, pg8::StaticOrder, PG8_ALIGN, PG8_SP2>(lds + RING_OFF, gp, Sp, Ep);
        }
    }
    if (IN(1)) DRAIN_BG(T_D1);
    SEAM_BG(1);
    if (IN(2)) {
        pg8::Gemm g{ACT, WD1, M, DM, DFF, DFF, DFF}; g.krev = 1; pg8::StaticOrder S; S.init(M, DM, G, bid, WGM_DOWN);
        pg8::EpiResidBf E{XB, HB, DM, 0.5f, SS1};
        pg8::gemm_phase<pg8::EpiResidBf, pg8::StaticOrder, PG8_ALIGN, PG8_SP2>(lds + RING_OFF, g, S, E);
    }
    if (IN(2)) DRAIN_BG(T_IN);
    SEAM_BG(2);
    if (IN(3)) {
        pg8::Gemm g{HB, WIN, M, INC, DM, DM, DM}; pg8::StaticOrder S; S.init(M, INC, G, bid, WGM_ALL);
        PREP_RS(RS, SS1, S); pg8::EpiBf16 E{QKV, 2 * HD, RS, (size_t)M * 2 * HD, 48, GAB, 2 * DM};
        pg8::gemm_phase<pg8::EpiBf16, pg8::StaticOrder, PG8_ALIGN, PG8_SP2>(lds + RING_OFF, g, S, E);
    }
    SEAM_BG(3);
    if (IN(4)) {
        LAS float* part = (LAS float*)(lds + RING_OFF);
        for (int u = bid; u < BATCH * NH * NBLK; u += G) {
            const int bh = u / NBLK, n = u % NBLK, b = bh / NH, h = bh % NH;
            const bf16* KAh = QKV + ((size_t)(1 * 8 + (h >> 1)) * M + (size_t)b * SEQ) * 2 * HD + (h & 1) * HD;
            const bf16* kp = KAh + (size_t)(n * MB + wave * 32) * 2 * HD + 2 * lane;
            float s0 = 0.f, s1 = 0.f;
#pragma unroll 8
            for (int r = 0; r < 32; ++r) { const unsigned w = *(const GAS unsigned*)(kp + (size_t)r * 2 * HD); s0 += __uint_as_float(w << 16); s1 += __uint_as_float(w & 0xffff0000u); }
            part[wave * 128 + 2 * lane] = s0; part[wave * 128 + 2 * lane + 1] = s1;
            { const bf16* rp = KAh + (size_t)(n * MB + wave * 32 + (lane >> 1)) * 2 * HD + (lane & 1) * 64; float q2 = 0.f;
#pragma unroll
              for (int j = 0; j < 8; ++j) { const v4u w4 = *(const GAS v4u*)(rp + 8 * j);
                  q2 += __uint_as_float(w4.x << 16) * __uint_as_float(w4.x << 16) + __uint_as_float(w4.x & 0xffff0000u) * __uint_as_float(w4.x & 0xffff0000u);
                  q2 += __uint_as_float(w4.y << 16) * __uint_as_float(w4.y << 16) + __uint_as_float(w4.y & 0xffff0000u) * __uint_as_float(w4.y & 0xffff0000u);
                  q2 += __uint_as_float(w4.z << 16) * __uint_as_float(w4.z << 16) + __uint_as_float(w4.z & 0xffff0000u) * __uint_as_float(w4.z & 0xffff0000u);
                  q2 += __uint_as_float(w4.w << 16) * __uint_as_float(w4.w << 16) + __uint_as_float(w4.w & 0xffff0000u) * __uint_as_float(w4.w & 0xffff0000u); }
              q2 += __shfl_xor(q2, 1);
#pragma unroll
              for (int o_ = 2; o_ < 64; o_ <<= 1) q2 = fmaxf(q2, __shfl_xor(q2, o_));
              if (lane == 0) part[1024 + wave] = q2; }
            LDS_WAIT(); __syncthreads();
            if (tid < 128) { float s = 0.f;
#pragma unroll
                for (int w = 0; w < 8; ++w) s += part[w * 128 + tid];
                KM[(size_t)u * HD + tid] = s * (1.0f / MB); }
            if (tid == 128) { float q2 = part[1024];
#pragma unroll
                for (int w = 1; w < 8; ++w) q2 = fmaxf(q2, part[1024 + w]);
                KN[u] = q2; }
            LDS_WAIT(); __syncthreads();
        }
    }
    SEAM_BG(4);
    if (IN(5)) {
        const bool x8 = (G & 7) == 0; const int grp = x8 ? (bid & 7) : 0, ngrp = x8 ? 8 : 1;
        const int nmo = 512 / ngrp, nsb = 1024 / ngrp;
        gu32* qhead = ctl + CW_QUEUE + 64 * grp;
#pragma unroll 1
        for (;;) {
            if (tid == 0) MISC[16] = __hip_atomic_fetch_add(qhead, 1u, RLX_AGENT);
            LDS_WAIT(); __syncthreads();
            const int i = (int)MISC[16];
            __syncthreads();
            if (i >= nmo) break;
            const int pr = i & 7, kk = i >> 3, bh = x8 ? (grp >> 1) * NH + ((grp & 1) + 2 * (7 - kk)) : 63 - kk, b = bh / NH, h = bh % NH;
            const float slope = exp2f(-0.5f * (float)(h + 1));
            const bf16* base = QKV + ((size_t)(h >> 1) * M + (size_t)b * SEQ) * 2 * HD + (h & 1) * HD;
#pragma unroll 1
            for (int pass = 0; pass < 2; ++pass) { const int qb = pass ? pr : 15 - pr;
                att::attn_unit<0>(base, base + (size_t)1 * M * AW, base + (size_t)2 * M * AW, ATT + (size_t)b * SEQ * DM + h * HD, qb, slope, KM + (size_t)bh * NBLK * HD, KN + bh * NBLK, (LAS char*)(lds + RING_OFF)); }
        }
#pragma unroll 1
        for (;;) {
            if (tid == 0) MISC[16] = __hip_atomic_fetch_add(qhead + 64 * 8, 1u, RLX_AGENT);
            LDS_WAIT(); __syncthreads();
            const int j = (int)MISC[16];
            __syncthreads();
            if (j >= nsb) break;
            const int bh = (x8 ? grp * 8 : 0) + (j >> 4), qb = j & 15, b = bh / NH, h = bh % NH;
            const bf16* base = QKV + ((size_t)(h >> 1) * M + (size_t)b * SEQ) * 2 * HD + (h & 1) * HD;
            att::attn_unit<1>(base + (size_t)3 * M * AW, base + (size_t)4 * M * AW, base + (size_t)5 * M * AW, ATT + (size_t)b * SEQ * DM + AW + h * HD, qb, 0.f, nullptr, nullptr, (LAS char*)(lds + RING_OFF));
        }
    }
    if (IN(5)) DRAIN_BG(T_BR);
    SEAM_BG(5);
    if (IN(6)) {
        { pg8::Gemm g{ATT, WBR, M, DM, AW, DM, 2 * AW}; pg8::StaticOrder S; S.init(M, DM, G, bid, WGM_ALL);
          pg8::EpiGate<false> E{GAB, 2 * DM, Z, DM};
          pg8::gemm_phase<pg8::EpiGate<false>, pg8::StaticOrder, PG8_ALIGN, PG8_SP2>(lds + RING_OFF, g, S, E); }
        { pg8::Gemm g{ATT + AW, WBR + AW, M, DM, AW, DM, 2 * AW}; pg8::StaticOrder S; S.init(M, DM, G, bid, WGM_ALL);
          pg8::EpiGate<true> E{GAB + DM, 2 * DM, Z, DM};
          pg8::gemm_phase<pg8::EpiGate<true>, pg8::StaticOrder, PG8_ALIGN, PG8_SP2>(lds + RING_OFF, g, S, E); }
    }
    if (IN(6)) DRAIN_BG(T_OUT);
    SEAM_BG(6);
    if (IN(7)) {
        { pg8::Gemm g{Z, WOUT, M, DM, DM, DM, DM}; pg8::StaticOrder S; S.init(M, DM, G, bid, WGM_ALL);
          pg8::EpiResidBf E{HB, HB, DM, 1.0f, SS2};
          pg8::gemm_phase<pg8::EpiResidBf, pg8::StaticOrder, PG8_ALIGN, PG8_SP2>(lds + RING_OFF, g, S, E); }
    }
    if (IN(7)) DRAIN_BG(NT_BG);
    SEAM(7);
    if (IN(8)) {
        if (!tailfill) { pg8::Gemm g{PBF, WPE, M, DM, PLE, PLE, PLE}; pg8::StaticOrder S; S.init(M, DM, G, bid, WGM_ALL);
          pg8::EpiBf16 E{PE, DM, pg8::RowScale{nullptr, rsl, -1}, 256, 1 << 30, nullptr, 0};
          pg8::gemm_phase<pg8::EpiBf16, pg8::StaticOrder, PG8_ALIGN, PG8_SP2>(lds + RING_OFF, g, S, E); }
        { pg8::Gemm g{HB, WGU2, M, 2 * DFF, DM, DM, DM}; pg8::StaticOrder S; S.init(M, 2 * DFF, G, bid, WGM_ALL);
          PREP_RS(RS, SS2, S); pg8::EpiSwiGLU E{ACT, DFF, RS};
          pg8::gemm_phase<pg8::EpiSwiGLU, pg8::StaticOrder, PG8_ALIGN, PG8_SP2>(lds + RING_OFF, g, S, E); }
        if (tailfill && bid >= 128) {
          pg8::Gemm g{PBF, WPE, M, DM, PLE, PLE, PLE}; pg8::StaticOrder S; S.init(M, DM, 128, bid - 128, WGM_ALL); S.L0 = 512;
          pg8::EpiBf16 E{PE, DM, pg8::RowScale{nullptr, rsl, -1}, 256, 1 << 30, nullptr, 0};
          pg8::gemm_phase<pg8::EpiBf16, pg8::StaticOrder, PG8_ALIGN, PG8_SP2>(lds + RING_OFF, g, S, E); }
    }
    SEAM(8);
    if (IN(9)) {
        pg8::Gemm g{ACT, WD2, M, DM, DFF, DFF, DFF}; g.krev = 1; pg8::StaticOrder S; S.init(M, DM, G, bid, WGM_DOWN);
        pg8::EpiResidBf E{HB, HB, DM, 0.5f, SS3};
        pg8::gemm_phase<pg8::EpiResidBf, pg8::StaticOrder, PG8_ALIGN, PG8_SP2>(lds + RING_OFF, g, S, E);
    }
    SEAM(9);
    if (IN(10)) {
        pg8::Gemm g{HB, WPG, M, DM, DM, DM, DM}; pg8::StaticOrder S; S.init(M, DM, G, bid, WGM_ALL);
        PREP_RS(RS, SS3, S); pg8::EpiPleOut E{HB, PE, HF, DM, RS};
        pg8::gemm_phase<pg8::EpiPleOut, pg8::StaticOrder, PG8_ALIGN, PG8_SP2>(lds + RING_OFF, g, S, E);
    }
    SEAM(10);
    if (IN(11)) { for (int m = gw; m < M; m += NGW) rms_row_out(HF + (size_t)m * DM, out + (size_t)m * DM, g_fin, lane); }
#undef IN
#undef SEAM
#undef SEAM_BG
#undef DRAIN_BG
#undef TRY_BG
#undef BG_CONV
}

extern "C" void kernel_launch(void* const* d_in, const int* in_sizes, int n_in, void* d_out, int out_size, void* d_ws, size_t ws_size, hipStream_t stream) {
    static int grid = 0;
    if (grid == 0) {
        if (n_in != 19 || in_sizes[0] != M * DM || out_size != M * DM || ws_size < WS_END) { fprintf(stderr, "kernel_launch: shape mismatch (n_in %d, in0 %d, out %d, ws %zu, need %zu); nothing launched\n", n_in, n_in > 0 ? in_sizes[0] : -1, out_size, ws_size, (size_t)WS_END); grid = -1; return; }
        int dev = 0, cus = 0, per_cu = 0;
        if (hipGetDevice(&dev) != hipSuccess || hipDeviceGetAttribute(&cus, hipDeviceAttributeMultiprocessorCount, dev) != hipSuccess) { fprintf(stderr, "kernel_launch: device query failed\n"); grid = -1; return; }
        if (hipFuncSetAttribute((const void*)mega_fwd, hipFuncAttributeMaxDynamicSharedMemorySize, LDS_BYTES) != hipSuccess) { fprintf(stderr, "kernel_launch: hipFuncSetAttribute failed\n"); grid = -1; return; }
        if (hipOccupancyMaxActiveBlocksPerMultiprocessor(&per_cu, (const void*)mega_fwd, NWAVES * 64, LDS_BYTES) != hipSuccess || per_cu < 1) fprintf(stderr, "kernel_launch: note: occupancy query reports %d blocks per CU\n", per_cu);
        (void)hipGetLastError();
        grid = cus;
        fprintf(stderr, "kernel_launch: grid %d, ws %zu (need %zu)\n", grid, ws_size, (size_t)WS_END);
    }
    if (grid < 0) return;
    if (hipMemsetAsync((char*)d_ws + WS_CTL, 0, CTL_ZERO_BYTES, stream) != hipSuccess) { fprintf(stderr, "kernel_launch: memset failed\n"); return; }
    Args a{};
    for (int i = 0; i < 19; ++i) a.in[i] = (const float*)d_in[i];
    a.out = (float*)d_out; a.ws = (unsigned char*)d_ws;
    for (int li = 0; li < MK_N_LAUNCHES; ++li) {
        a.ph_lo = (MK_N_LAUNCHES == 1) ? 0 : li; a.ph_hi = (MK_N_LAUNCHES == 1) ? N_PHASES : li + 1;
        hipLaunchKernelGGL(mega_fwd, dim3(grid), dim3(NWAVES * 64), LDS_BYTES, stream, a);
        const hipError_t le = hipPeekAtLastError();
        if (le != hipSuccess) { fprintf(stderr, "kernel_launch: launch %d failed: %s\n", li, hipGetErrorName(le)); break; }
    }
}
```

```cpp
#include <hip/hip_runtime.h>
#include <cstdio>
#include <cstdint>
#include <cmath>
namespace pg8 {
#define PG8_LAS __attribute__((address_space(3)))
typedef unsigned short bf16_t;
typedef short bf16x8 __attribute__((ext_vector_type(8)));
typedef float f32x4 __attribute__((ext_vector_type(4)));
typedef unsigned u32x4 __attribute__((ext_vector_type(4)));
constexpr int BM = 256, BK = 64, HALF = 128, HTB = HALF * BK * 2  , STAGE_BYTES = 8 * HTB, NXCD = 8;

__host__ __device__ __forceinline__ int lds_byte(int r, int c) { const int st = (r >> 4) * 2 + (c >> 5), rr = r & 15, cc = c & 31, ob = rr * 64 + cc * 2; return st * 1024 + (ob ^ (((ob >> 9) & 1) << 5)); }
__host__ __device__ __forceinline__ void stage_rc(int b, int& R, int& C) { const int st = b / 1024, sb = b % 1024, swz = sb ^ (((sb >> 9) & 1) << 5); R = (st >> 1) * 16 + swz / 64; C = (st & 1) * 32 + (swz % 64) / 2; }
__host__ __device__ __forceinline__ int perm32(int rho) { const int n = rho >> 4, i = rho & 15; return 8 * (i >> 2) + 4 * n + (i & 3); }

struct Unit { int pm, pn; };
struct Gemm { const bf16_t* A; const bf16_t* Bt; int M, N, K, lda, ldb; int pmulA = 1, pmulB = 1; int krev = 0; };

struct StaticOrder {
    int nM, nN, nwg, G, c, WGM, L0, Lend;
    __host__ __device__ __forceinline__ void init(int M, int N, int G_, int c_, int wgm = 8) { nM = M / BM; nN = N / BM; nwg = nM * nN; G = G_; c = c_; WGM = wgm; L0 = 0; Lend = nwg; }
    __host__ __device__ __forceinline__ bool next(int i, Unit& u) const {
        const long L = (long)L0 + (long)i * G + c; if (L >= Lend) return false;
        int wgid = (int)L; { const int q = nwg / NXCD, r = nwg % NXCD, xcd = wgid % NXCD, off = wgid / NXCD; wgid = (xcd < r ? xcd * (q + 1) : r * (q + 1) + (xcd - r) * q) + off; }
        const int nig = WGM * nN, gid = wgid / nig, fm = gid * WGM, gsz = (nM - fm) < WGM ? (nM - fm) : WGM;
        u.pm = fm + ((wgid % nig) % gsz); u.pn = (wgid % nig) / gsz; return true;
    }
    __device__ __forceinline__ void a_ready(const Unit&) const {}
    __device__ __forceinline__ void done(const Unit&) const {}
};

__device__ __forceinline__ unsigned cvt_pk_bf16(float lo, float hi) { unsigned r; asm volatile("v_cvt_pk_bf16_f32 %0, %1, %2" : "=v"(r) : "v"(lo), "v"(hi)); return r; }
typedef unsigned u32x2 __attribute__((ext_vector_type(2)));
__device__ __forceinline__ float sigm(float x) { return __builtin_amdgcn_rcpf(1.0f + __builtin_amdgcn_exp2f(-1.4426950408889634f * x)); }
__device__ __forceinline__ float bf_lo(unsigned w) { return __uint_as_float(w << 16); }
__device__ __forceinline__ float bf_hi(unsigned w) { return __uint_as_float(w & 0xffff0000u); }

struct RowScale { const float* SS; const PG8_LAS float* rsl; int pm0; };
__device__ __forceinline__ void load_rstd(float (&rs)[2][4], const RowScale& R, int pm, int r0) {
    if (!R.SS) {
#pragma unroll
        for (int ai = 0; ai < 2; ++ai)
#pragma unroll
            for (int m = 0; m < 4; ++m) rs[ai][m] = 1.0f;
        return; }
    if (pm == R.pm0) {
#pragma unroll
        for (int ai = 0; ai < 2; ++ai)
#pragma unroll
            for (int m = 0; m < 4; ++m) rs[ai][m] = R.rsl[r0 + ai * HALF + m * 16];
        return; }
#pragma unroll
    for (int ai = 0; ai < 2; ++ai)
#pragma unroll
        for (int m = 0; m < 4; ++m) rs[ai][m] = __builtin_amdgcn_rsqf(R.SS[pm * BM + r0 + ai * HALF + m * 16] * (1.0f / 4096.0f) + 1e-6f);
}
struct EpiBf16 {
    static constexpr bool PERM = true, AFTER_DRAIN = false;
    bf16_t* O; int ldc; RowScale RS; size_t ts; int split; bf16_t* O2; int ldc2;
    __device__ __forceinline__ void operator()(const f32x4 (&acc)[2][2][4][2], const Unit& u, int wr, int wc, int fr, int fq) const {
        const bool first = u.pn < split;
        const int row0 = u.pm * BM + wr * 64 + fr, cw = wc * 32 + 8 * fq, ld = first ? ldc : ldc2;
        bf16_t* tb = first ? O + (size_t)u.pn * ts : O2 + (size_t)(u.pn - split) * BM;
        float rsv[2][4]; load_rstd(rsv, RS, u.pm, wr * 64 + fr);
#pragma unroll
        for (int ai = 0; ai < 2; ++ai)
#pragma unroll
            for (int m = 0; m < 4; ++m) { const int row = row0 + ai * HALF + m * 16; bf16_t* rowp = tb + (size_t)row * ld + cw; const float r = rsv[ai][m];
#pragma unroll
                for (int bj = 0; bj < 2; ++bj) { const f32x4 v0 = acc[ai][bj][m][0] * r, v1 = acc[ai][bj][m][1] * r;
                    u32x4 w; w.x = cvt_pk_bf16(v0[0], v0[1]); w.y = cvt_pk_bf16(v0[2], v0[3]); w.z = cvt_pk_bf16(v1[0], v1[1]); w.w = cvt_pk_bf16(v1[2], v1[3]);
                    *(u32x4*)(rowp + bj * HALF) = w; } }
    }
};
struct EpiSwiGLU {
    static constexpr bool PERM = true, AFTER_DRAIN = false;
    bf16_t* O; int ldc; RowScale RS;
    __device__ __forceinline__ void operator()(const f32x4 (&acc)[2][2][4][2], const Unit& u, int wr, int wc, int fr, int fq) const {
        const int row0 = u.pm * BM + wr * 64 + fr, col0 = u.pn * HALF + wc * 32 + 8 * fq;
        float rsv[2][4]; load_rstd(rsv, RS, u.pm, wr * 64 + fr);
#pragma unroll
        for (int ai = 0; ai < 2; ++ai)
#pragma unroll
            for (int m = 0; m < 4; ++m) { const int row = row0 + ai * HALF + m * 16; bf16_t* rowp = O + (size_t)row * ldc + col0; const float rs = rsv[ai][m];
                const float ka = -1.4426950408889634f * rs, kb = rs * rs;
                const f32x4 g0 = acc[ai][0][m][0], g1 = acc[ai][0][m][1], u0 = acc[ai][1][m][0], u1 = acc[ai][1][m][1];
                f32x4 e0 = g0 * ka, e1 = g1 * ka;
#pragma unroll
                for (int j = 0; j < 4; ++j) { e0[j] = __builtin_amdgcn_exp2f(e0[j]); e1[j] = __builtin_amdgcn_exp2f(e1[j]); }
                e0 = e0 + 1.0f; e1 = e1 + 1.0f;
#pragma unroll
                for (int j = 0; j < 4; ++j) { e0[j] = __builtin_amdgcn_rcpf(e0[j]); e1[j] = __builtin_amdgcn_rcpf(e1[j]); }
                const f32x4 t0 = ((g0 * u0) * kb) * e0, t1 = ((g1 * u1) * kb) * e1;
                u32x4 w; w.x = cvt_pk_bf16(t0[0], t0[1]); w.y = cvt_pk_bf16(t0[2], t0[3]); w.z = cvt_pk_bf16(t1[0], t1[1]); w.w = cvt_pk_bf16(t1[2], t1[3]);
                *(u32x4*)rowp = w; }
    }
};
struct EpiResidBf {
    static constexpr bool PERM = true, AFTER_DRAIN = false;
    const bf16_t* Hin; bf16_t* Hout; int ldc; float alpha; float* SS;
    __device__ __forceinline__ void operator()(const f32x4 (&acc)[2][2][4][2], const Unit& u, int wr, int wc, int fr, int fq) const {
        const int row0 = u.pm * BM + wr * 64 + fr, col0 = u.pn * BM + wc * 32 + 8 * fq;
        u32x4 hw[2][4][2];
#pragma unroll
        for (int ai = 0; ai < 2; ++ai)
#pragma unroll
            for (int m = 0; m < 4; ++m)
#pragma unroll
                for (int bj = 0; bj < 2; ++bj) hw[ai][m][bj] = *(const u32x4*)(Hin + (size_t)(row0 + ai * HALF + m * 16) * ldc + col0 + bj * HALF);
#pragma unroll
        for (int ai = 0; ai < 2; ++ai)
#pragma unroll
            for (int m = 0; m < 4; ++m) { const int row = row0 + ai * HALF + m * 16; float ssq = 0.f;
#pragma unroll
                for (int bj = 0; bj < 2; ++bj) { const size_t p = (size_t)row * ldc + col0 + bj * HALF; float r[8]; const u32x4 h4 = hw[ai][m][bj];
                    r[0] = bf_lo(h4.x); r[1] = bf_hi(h4.x); r[2] = bf_lo(h4.y); r[3] = bf_hi(h4.y); r[4] = bf_lo(h4.z); r[5] = bf_hi(h4.z); r[6] = bf_lo(h4.w); r[7] = bf_hi(h4.w);
                    const f32x4 v0 = acc[ai][bj][m][0], v1 = acc[ai][bj][m][1];
#pragma unroll
                    for (int j = 0; j < 4; ++j) { r[j] += alpha * v0[j]; r[4 + j] += alpha * v1[j]; }
#pragma unroll
                    for (int j = 0; j < 8; ++j) ssq += r[j] * r[j];
                    u32x4 w; w.x = cvt_pk_bf16(r[0], r[1]); w.y = cvt_pk_bf16(r[2], r[3]); w.z = cvt_pk_bf16(r[4], r[5]); w.w = cvt_pk_bf16(r[6], r[7]);
                    *(u32x4*)(Hout + p) = w; }
                ssq += __shfl_xor(ssq, 16); ssq += __shfl_xor(ssq, 32);
                if (fq == 0) (void)__hip_atomic_fetch_add(SS + row, ssq, __ATOMIC_RELAXED, __HIP_MEMORY_SCOPE_AGENT); }
    }
};
struct EpiPleOut {
    static constexpr bool PERM = true, AFTER_DRAIN = false;
    const bf16_t* H; const bf16_t* PE; bf16_t* O; int ldc; RowScale RS;
    __device__ __forceinline__ void operator()(const f32x4 (&acc)[2][2][4][2], const Unit& u, int wr, int wc, int fr, int fq) const {
        const int row0 = u.pm * BM + wr * 64 + fr, col0 = u.pn * BM + wc * 32 + 8 * fq;
        float rsv[2][4]; load_rstd(rsv, RS, u.pm, wr * 64 + fr);
#pragma unroll
        for (int ai = 0; ai < 2; ++ai) {
            u32x4 hq[4][2], pq[4][2];
#pragma unroll
            for (int m = 0; m < 4; ++m)
#pragma unroll
                for (int bj = 0; bj < 2; ++bj) { const size_t p = (size_t)(row0 + ai * HALF + m * 16) * ldc + col0 + bj * HALF; hq[m][bj] = *(const u32x4*)(H + p); pq[m][bj] = *(const u32x4*)(PE + p); }
#pragma unroll
            for (int m = 0; m < 4; ++m) { const int row = row0 + ai * HALF + m * 16; const float rs = rsv[ai][m];
#pragma unroll
                for (int bj = 0; bj < 2; ++bj) { const size_t p = (size_t)row * ldc + col0 + bj * HALF; const u32x4 hw = hq[m][bj], pw = pq[m][bj];
                    const float ka = -1.4426950408889634f * rs;
                    f32x4 e0 = acc[ai][bj][m][0] * ka, e1 = acc[ai][bj][m][1] * ka;
#pragma unroll
                    for (int j = 0; j < 4; ++j) { e0[j] = __builtin_amdgcn_exp2f(e0[j]); e1[j] = __builtin_amdgcn_exp2f(e1[j]); }
                    e0 = e0 + 1.0f; e1 = e1 + 1.0f;
#pragma unroll
                    for (int j = 0; j < 4; ++j) { e0[j] = __builtin_amdgcn_rcpf(e0[j]); e1[j] = __builtin_amdgcn_rcpf(e1[j]); }
                    const f32x4 h0 = {bf_lo(hw.x), bf_hi(hw.x), bf_lo(hw.y), bf_hi(hw.y)}, h1 = {bf_lo(hw.z), bf_hi(hw.z), bf_lo(hw.w), bf_hi(hw.w)};
                    const f32x4 q0 = {bf_lo(pw.x), bf_hi(pw.x), bf_lo(pw.y), bf_hi(pw.y)}, q1 = {bf_lo(pw.z), bf_hi(pw.z), bf_lo(pw.w), bf_hi(pw.w)};
                    const f32x4 o0 = h0 + e0 * q0, o1 = h1 + e1 * q1;
                    u32x4 w; w.x = cvt_pk_bf16(o0[0], o0[1]); w.y = cvt_pk_bf16(o0[2], o0[3]); w.z = cvt_pk_bf16(o1[0], o1[1]); w.w = cvt_pk_bf16(o1[2], o1[3]);
                    *(u32x4*)(O + p) = w; } } }
    }
};
template <bool ACCUM> struct EpiGate {
    static constexpr bool PERM = true, AFTER_DRAIN = false;
    const bf16_t* G; int ldg; bf16_t* Z; int ldz;
    __device__ __forceinline__ void operator()(const f32x4 (&acc)[2][2][4][2], const Unit& u, int wr, int wc, int fr, int fq) const {
        const int row0 = u.pm * BM + wr * 64 + fr, col0 = u.pn * BM + wc * 32 + 8 * fq;
#pragma unroll
        for (int ai = 0; ai < 2; ++ai) {
            u32x4 gq[4][2], zq[4][2];
#pragma unroll
            for (int m = 0; m < 4; ++m)
#pragma unroll
                for (int bj = 0; bj < 2; ++bj) { const size_t row = (size_t)(row0 + ai * HALF + m * 16); gq[m][bj] = *(const u32x4*)(G + row * ldg + col0 + bj * HALF);
                    if (ACCUM) zq[m][bj] = *(const u32x4*)(Z + row * ldz + col0 + bj * HALF); }
#pragma unroll
            for (int m = 0; m < 4; ++m) { const size_t row = (size_t)(row0 + ai * HALF + m * 16);
#pragma unroll
                for (int bj = 0; bj < 2; ++bj) { const u32x4 gw = gq[m][bj]; bf16_t* zp = Z + row * ldz + col0 + bj * HALF;
                    const f32x4 v0 = acc[ai][bj][m][0], v1 = acc[ai][bj][m][1];
                    f32x4 e0 = {bf_lo(gw.x), bf_hi(gw.x), bf_lo(gw.y), bf_hi(gw.y)}, e1 = {bf_lo(gw.z), bf_hi(gw.z), bf_lo(gw.w), bf_hi(gw.w)};
                    e0 = e0 * -1.4426950408889634f; e1 = e1 * -1.4426950408889634f;
#pragma unroll
                    for (int j = 0; j < 4; ++j) { e0[j] = __builtin_amdgcn_exp2f(e0[j]); e1[j] = __builtin_amdgcn_exp2f(e1[j]); }
                    e0 = e0 + 1.0f; e1 = e1 + 1.0f;
#pragma unroll
                    for (int j = 0; j < 4; ++j) { e0[j] = __builtin_amdgcn_rcpf(e0[j]); e1[j] = __builtin_amdgcn_rcpf(e1[j]); }
                    f32x4 r0 = e0 * v0, r1 = e1 * v1;
                    if (ACCUM) { const u32x4 zw = zq[m][bj];
                        r0 = r0 + (f32x4){bf_lo(zw.x), bf_hi(zw.x), bf_lo(zw.y), bf_hi(zw.y)}; r1 = r1 + (f32x4){bf_lo(zw.z), bf_hi(zw.z), bf_lo(zw.w), bf_hi(zw.w)}; }
                    u32x4 w; w.x = cvt_pk_bf16(r0[0], r0[1]); w.y = cvt_pk_bf16(r0[2], r0[3]); w.z = cvt_pk_bf16(r1[0], r1[1]); w.w = cvt_pk_bf16(r1[2], r1[3]);
                    *(u32x4*)zp = w; } } }
    }
};

template <class Epi, class Sched, bool ALIGN_EPI = false, bool SP2 = false>
__device__ __forceinline__ void gemm_phase(PG8_LAS unsigned char* lds, const Gemm g, const Sched& S, const Epi& E) {
    const int tid = threadIdx.x, wid = __builtin_amdgcn_readfirstlane(tid >> 6), lane = tid & 63, wr = wid >> 2, wc = wid & 3, fr = lane & 15, fq = lane >> 4;
    const int K = g.K, nt = K / BK;
    unsigned voffA[2], voffB[2];
#pragma unroll
    for (int i = 0; i < 2; ++i) { int R, C; stage_rc(tid * 16 + i * 8192, R, C); const int Rb = Epi::PERM ? ((R & ~31) + perm32(R & 31)) : R;
        voffA[i] = (unsigned)(R * g.lda + C) * 2u; voffB[i] = (unsigned)(Rb * g.ldb + C) * 2u; }
    const long kstep = g.krev ? -(long)(BK * 2) : (long)(BK * 2);
    const size_t kfirst = g.krev ? (size_t)(K / BK - 1) * (BK * 2) : 0;
    const size_t hstepA = (size_t)HALF * g.lda * 2, hstepB = (size_t)HALF * g.ldb * 2;
    const size_t tstepA = 2 * hstepA, tstepB = 2 * hstepB;
    const unsigned ldsw = (unsigned)wid * 1024u;
    const int aoff = lds_byte(wr * 64 + fr, fq * 8), boff = lds_byte(wc * 32 + fr, fq * 8);
#define PG8_SA(b, h) (((b) * 2 + (h)) * HTB)
#define PG8_SB(b, h) ((4 + (b) * 2 + (h)) * HTB)
#define PG8_STAGE(bufoff, gbase, voff) do { _Pragma("unroll") for (int _i = 0; _i < 2; ++_i) \
        __builtin_amdgcn_global_load_lds((const unsigned*)((const char*)(gbase) + (voff)[_i]), (PG8_LAS unsigned*)(lds + (bufoff) + ldsw + _i * 8192), 16, 0, 0); } while (0)
#define PG8_LDA(dst, b, h) do { _Pragma("unroll") for (int m = 0; m < 4; ++m) _Pragma("unroll") for (int k = 0; k < 2; ++k) dst[m][k] = *(const PG8_LAS bf16x8*)(lds + PG8_SA(b, h) + aoff + m * 2048 + k * 1024); } while (0)
#define PG8_LDB(dst, b, h) do { _Pragma("unroll") for (int n = 0; n < 2; ++n) _Pragma("unroll") for (int k = 0; k < 2; ++k) dst[n][k] = *(const PG8_LAS bf16x8*)(lds + PG8_SB(b, h) + boff + n * 2048 + k * 1024); } while (0)
#define PG8_MMA(ai, bj, At, Bt) do { __builtin_amdgcn_s_setprio(1); _Pragma("unroll") for (int m = 0; m < 4; ++m) _Pragma("unroll") for (int n = 0; n < 2; ++n) _Pragma("unroll") for (int k = 0; k < 2; ++k) \
        acc[ai][bj][m][n] = __builtin_amdgcn_mfma_f32_16x16x32_bf16(Bt[n][k], At[m][k], acc[ai][bj][m][n], 0, 0, 0); __builtin_amdgcn_s_setprio(0); } while (0)
#define PG8_WAIT_V(n) asm volatile("s_waitcnt vmcnt(" #n ")" ::: "memory")
#define PG8_WAIT_L(n) asm volatile("s_waitcnt lgkmcnt(" #n ")" ::: "memory")
#define PG8_BAR __builtin_amdgcn_s_barrier()
#define PG8_SCHED __builtin_amdgcn_sched_barrier(0)
    Unit cur, nxt; int ui = 0;
    if (!S.next(0, cur)) return;
    f32x4 acc[2][2][4][2];
#pragma unroll
    for (int a = 0; a < 2; ++a)
#pragma unroll
        for (int b = 0; b < 2; ++b)
#pragma unroll
            for (int m = 0; m < 4; ++m)
#pragma unroll
                for (int n = 0; n < 2; ++n) acc[a][b][m][n] = (f32x4){0.f, 0.f, 0.f, 0.f};
    bf16x8 At[4][2], B0[2][2], B1[2][2];
    const char* cA = (const char*)g.A + (size_t)(cur.pm * g.pmulA) * tstepA + kfirst; const char* cB = (const char*)g.Bt + (size_t)(cur.pn * g.pmulB) * tstepB + kfirst;
    S.a_ready(cur);
    if constexpr (SP2) {
        PG8_STAGE(PG8_SB(0, 0), cB, voffB); PG8_STAGE(PG8_SB(0, 1), cB + hstepB, voffB); PG8_STAGE(PG8_SA(0, 0), cA, voffA); PG8_STAGE(PG8_SA(0, 1), cA + hstepA, voffA);
        if (wr == 1) PG8_BAR;
        PG8_WAIT_V(2); PG8_BAR;
        PG8_STAGE(PG8_SB(1, 0), cB + kstep, voffB); PG8_STAGE(PG8_SA(1, 0), cA + kstep, voffA); PG8_STAGE(PG8_SB(1, 1), cB + hstepB + kstep, voffB);
        PG8_WAIT_V(6); PG8_BAR;
    } else {
        PG8_STAGE(PG8_SB(0, 0), cB, voffB); PG8_STAGE(PG8_SA(0, 0), cA, voffA); PG8_STAGE(PG8_SB(0, 1), cB + hstepB, voffB); PG8_STAGE(PG8_SA(0, 1), cA + hstepA, voffA);
        if (wr == 1) PG8_BAR;
        PG8_WAIT_V(4); PG8_BAR;
        PG8_STAGE(PG8_SB(1, 0), cB + kstep, voffB); PG8_STAGE(PG8_SA(1, 0), cA + kstep, voffA); PG8_STAGE(PG8_SB(1, 1), cB + hstepB + kstep, voffB);
        PG8_WAIT_V(6); PG8_BAR;
    }
    for (;;) {
        const bool has_next = S.next(ui + 1, nxt);
        const char* nA = has_next ? (const char*)g.A + (size_t)(nxt.pm * g.pmulA) * tstepA + kfirst : cA; const char* nB = has_next ? (const char*)g.Bt + (size_t)(nxt.pn * g.pmulB) * tstepB + kfirst : cB;
        for (int t = 0; t < nt; t += 2) {
            const bool last = (t == nt - 2);
            const char* a1 = cA + (long)(t + 1) * kstep;
            const char* a2 = last ? nA : cA + (long)(t + 2) * kstep; const char* b2 = last ? nB : cB + (long)(t + 2) * kstep;
            const char* a3 = a2 + kstep; const char* b3 = b2 + kstep;
            if (last && has_next) S.a_ready(nxt);
            if constexpr (SP2) {
            PG8_LDB(B0, 0, 0); PG8_LDB(B1, 0, 1); PG8_SCHED; PG8_LDA(At, 0, 0); PG8_STAGE(PG8_SA(1, 1), a1 + hstepA, voffA);
            PG8_WAIT_V(8); PG8_WAIT_L(0); PG8_BAR; PG8_MMA(0, 0, At, B0); PG8_MMA(0, 1, At, B1); PG8_BAR; PG8_SCHED;
            PG8_LDA(At, 0, 1); PG8_STAGE(PG8_SB(0, 0), b2, voffB); PG8_STAGE(PG8_SB(0, 1), b2 + hstepB, voffB); PG8_STAGE(PG8_SA(0, 0), a2, voffA);
            PG8_WAIT_V(8); PG8_WAIT_L(0); PG8_BAR; PG8_MMA(1, 0, At, B0); PG8_MMA(1, 1, At, B1); PG8_BAR; PG8_SCHED;
            PG8_LDB(B0, 1, 0); PG8_LDB(B1, 1, 1); PG8_SCHED; PG8_LDA(At, 1, 0); PG8_STAGE(PG8_SA(0, 1), a2 + hstepA, voffA);
            PG8_WAIT_V(8); PG8_WAIT_L(0); PG8_BAR; PG8_MMA(0, 0, At, B0); PG8_MMA(0, 1, At, B1); PG8_BAR; PG8_SCHED;
            PG8_LDA(At, 1, 1); PG8_STAGE(PG8_SB(1, 0), b3, voffB); PG8_STAGE(PG8_SB(1, 1), b3 + hstepB, voffB); PG8_STAGE(PG8_SA(1, 0), a3, voffA);
            PG8_WAIT_V(8); PG8_WAIT_L(0); PG8_BAR; PG8_MMA(1, 0, At, B0); PG8_MMA(1, 1, At, B1); PG8_BAR; PG8_SCHED;
            } else {
            PG8_LDB(B0, 0, 0); PG8_SCHED; PG8_LDA(At, 0, 0); PG8_STAGE(PG8_SA(1, 1), a1 + hstepA, voffA);
            PG8_WAIT_L(8); PG8_BAR; PG8_WAIT_L(0); PG8_MMA(0, 0, At, B0); PG8_BAR; PG8_SCHED;
            PG8_LDB(B1, 0, 1); PG8_STAGE(PG8_SB(0, 0), b2, voffB);
            PG8_BAR; PG8_WAIT_L(0); PG8_MMA(0, 1, At, B1); PG8_BAR;
            PG8_LDA(At, 0, 1); PG8_STAGE(PG8_SA(0, 0), a2, voffA);
            PG8_BAR; PG8_WAIT_L(0); PG8_MMA(1, 0, At, B0); PG8_BAR; PG8_SCHED;
            PG8_STAGE(PG8_SB(0, 1), b2 + hstepB, voffB);
            PG8_WAIT_V(6); PG8_BAR; PG8_MMA(1, 1, At, B1); PG8_BAR;
            PG8_LDB(B0, 1, 0); PG8_SCHED; PG8_LDA(At, 1, 0); PG8_STAGE(PG8_SA(0, 1), a2 + hstepA, voffA);
            PG8_WAIT_L(8); PG8_BAR; PG8_WAIT_L(0); PG8_MMA(0, 0, At, B0); PG8_BAR; PG8_SCHED;
            PG8_LDB(B1, 1, 1); PG8_STAGE(PG8_SB(1, 0), b3, voffB);
            PG8_BAR; PG8_WAIT_L(0); PG8_MMA(0, 1, At, B1); PG8_BAR;
            PG8_LDA(At, 1, 1); PG8_STAGE(PG8_SA(1, 0), a3, voffA);
            PG8_BAR; PG8_WAIT_L(0); PG8_MMA(1, 0, At, B0); PG8_BAR; PG8_SCHED;
            PG8_STAGE(PG8_SB(1, 1), b3 + hstepB, voffB);
            PG8_WAIT_V(6); PG8_BAR; PG8_MMA(1, 1, At, B1); PG8_BAR;
            }
        }
        if constexpr (ALIGN_EPI) { if (wr == 0) PG8_BAR; }
        if constexpr (!Epi::AFTER_DRAIN) { E(acc, cur, wr, wc, fr, fq); S.done(cur); }
        if (!has_next) break;
#pragma unroll
        for (int a = 0; a < 2; ++a)
#pragma unroll
            for (int b = 0; b < 2; ++b)
#pragma unroll
                for (int m = 0; m < 4; ++m)
#pragma unroll
                    for (int n = 0; n < 2; ++n) acc[a][b][m][n] = (f32x4){0.f, 0.f, 0.f, 0.f};
        cur = nxt; cA = nA; cB = nB; ++ui;
        if constexpr (ALIGN_EPI) { if (wr == 1) PG8_BAR; }
    }
    PG8_WAIT_V(0);
    if constexpr (!ALIGN_EPI) { if (wr == 0) PG8_BAR; }
    PG8_BAR;
    if constexpr (Epi::AFTER_DRAIN) { E.fused(acc, cur, wr, wc, fr, fq, lds, wid, lane); S.done(cur); }
#undef PG8_SA
#undef PG8_SB
#undef PG8_STAGE
#undef PG8_LDA
#undef PG8_LDB
#undef PG8_MMA
#undef PG8_WAIT_V
#undef PG8_WAIT_L
#undef PG8_BAR
#undef PG8_SCHED
}
}

#ifndef WGM_ALL
#define WGM_ALL 8
#endif
#ifndef WGM_DOWN
#define WGM_DOWN 2
#endif
#ifndef PG8_SP2
#define PG8_SP2 true
#endif
#ifndef PG8_ALIGN
#define PG8_ALIGN true
#endif
constexpr int NWAVES = 8;
constexpr int BATCH = 4, SEQ = 4096, DM = 4096, M = BATCH * SEQ;
constexpr int DFF = 11008, PLE = 256, HD = 128, NH = 16, AW = NH * HD;
constexpr int INC = 6 * AW + 2 * DM;
constexpr int C_QA = 0, C_KA = AW, C_VA = 2 * AW, C_QB = 3 * AW, C_KB = 4 * AW, C_VB = 5 * AW, C_GA = 6 * AW, C_GB = 6 * AW + DM;
constexpr int MB = 256, NBLK = SEQ / MB;
constexpr float RMS_EPS = 1e-6f;
#ifndef MK_N_LAUNCHES
#define MK_N_LAUNCHES 1
#endif
constexpr int N_PHASES = 12;
static_assert(MK_N_LAUNCHES == 1 || MK_N_LAUNCHES == N_PHASES, "MK_N_LAUNCHES is 1 (one launch) or 12 (one launch per phase: debugging)");

constexpr size_t MiB = 1u << 20;
constexpr size_t WS_CTL = 0, CTL_ZERO_BYTES = 512 * 1024;
constexpr size_t WS_KM   = 1 * MiB;
constexpr size_t WS_WGU1 = 2 * MiB;
constexpr size_t WS_WD1  = WS_WGU1 + (size_t)2 * DFF * DM * 2;
constexpr size_t WS_WIN  = WS_WD1 + (size_t)DM * DFF * 2;
constexpr size_t WS_WBR  = WS_WIN + (size_t)INC * DM * 2;
constexpr size_t WS_WOUT = WS_WBR + (size_t)DM * 2 * AW * 2;
constexpr size_t WS_WGU2 = WS_WOUT + (size_t)DM * DM * 2;
constexpr size_t WS_WD2  = WS_WGU2 + (size_t)2 * DFF * DM * 2;
constexpr size_t WS_WPG  = WS_WD2 + (size_t)DM * DFF * 2;
constexpr size_t WS_WPE  = WS_WPG + (size_t)DM * DM * 2;
constexpr size_t WS_PBF  = WS_WPE + (size_t)DM * PLE * 2;
constexpr size_t WS_XBZ  = WS_PBF + (size_t)M * PLE * 2;
constexpr size_t WS_HB   = WS_XBZ + (size_t)M * DM * 2;
constexpr size_t WS_ATT  = WS_HB + (size_t)M * DM * 2;
constexpr size_t WS_R1   = WS_ATT + (size_t)M * DM * 2;
constexpr size_t WS_END  = WS_R1 + (size_t)M * INC * 2;
static_assert(WS_END <= (size_t)1908490240, "d_ws map must fit the guaranteed workspace (sum of the inputs)");
static_assert((WS_WD1 % 256) == 0 && (WS_WIN % 256) == 0 && (WS_XBZ % 256) == 0 && (WS_R1 % 256) == 0, "alignment");
constexpr size_t WS_SS0 = 448 * 1024, WS_SS1 = 256 * 1024, WS_SS2 = 320 * 1024, WS_SS3 = 384 * 1024;
constexpr int CW_TMO = 0, CW_CODE = 1;
constexpr int CW_BG = 12288;
constexpr int CW_QUEUE = 8192;
constexpr int CW_BAR = 4096;

constexpr int RING_OFF = 0, RING_BYTES = 135168;
constexpr int LDSCTL_OFF = RING_BYTES, MISC_OFF = LDSCTL_OFF + 320;
constexpr int LDS_BYTES = 147456;
static_assert(MISC_OFF + 128 <= LDS_BYTES, "LDS map");

#define GAS __attribute__((address_space(1)))
#define LAS __attribute__((address_space(3)))
typedef unsigned short bf16;
typedef unsigned v4u __attribute__((ext_vector_type(4)));
typedef unsigned v2u __attribute__((ext_vector_type(2)));
typedef float f32x4 __attribute__((ext_vector_type(4)));
typedef float f32x16 __attribute__((ext_vector_type(16)));
typedef short bf16x8 __attribute__((ext_vector_type(8)));
typedef short s16x4 __attribute__((ext_vector_type(4)));
typedef GAS unsigned gu32;
#define RLX_AGENT __ATOMIC_RELAXED, __HIP_MEMORY_SCOPE_AGENT
#define LDS_WAIT() asm volatile("s_waitcnt lgkmcnt(0)" ::: "memory")
#define VM_WAIT() asm volatile("s_waitcnt vmcnt(0)" ::: "memory")
#define SBAR() __builtin_amdgcn_sched_barrier(0)
__device__ __forceinline__ unsigned cvtpk(float lo, float hi) { unsigned r; asm volatile("v_cvt_pk_bf16_f32 %0, %1, %2" : "=v"(r) : "v"(lo), "v"(hi)); return r; }
typedef __bf16 bf16x2_t __attribute__((ext_vector_type(2)));
typedef float f32x2_t __attribute__((ext_vector_type(2)));
__device__ __forceinline__ unsigned cvtpk_c(float lo, float hi) { f32x2_t v = {lo, hi}; bf16x2_t b = __builtin_convertvector(v, bf16x2_t); return __builtin_bit_cast(unsigned, b); }

#define XB_TMO      128
#define XB_XCNT(j)  (256  + 64 * (j))
#define XB_XSUB(j)  (1280 + 64 * (j))
#define XB_XGEN(j)  (2304 + 64 * (j))
#define XB_TOP      3328
#define XB_TOPGEN   3392
#define XCD_BAR_WORDS 3456
#define XB_SPIN_CAP (1u << 18)

__device__ __forceinline__ unsigned xb_ld(unsigned* p)              { return __hip_atomic_load(p, __ATOMIC_RELAXED, __HIP_MEMORY_SCOPE_AGENT); }
__device__ __forceinline__ unsigned xb_add(unsigned* p, unsigned v) { return __hip_atomic_fetch_add(p, v, __ATOMIC_RELAXED, __HIP_MEMORY_SCOPE_AGENT); }
__device__ __forceinline__ unsigned xb_xcc_id() { return (unsigned)__builtin_amdgcn_s_getreg((3 << 11) | 20) & 0xFu; }
#define XB_SPIN(cond, bar) do { unsigned _sp = 0; while (cond) { __builtin_amdgcn_s_sleep(1); \
    if ((++_sp & 255u) == 0u) { if (xb_ld(&(bar)[XB_TMO])) break; if (_sp > XB_SPIN_CAP) { atomicAdd(&(bar)[XB_TMO], 1u); break; } } } } while (0)

struct XcdBarrier {
    unsigned* bar; unsigned x;
    volatile LAS unsigned* st;
};

__device__ __forceinline__ XcdBarrier xcd_barrier_post(unsigned* bar, volatile LAS unsigned* st) {
    XcdBarrier b; b.bar = bar; b.x = xb_xcc_id(); b.st = st;
    if (threadIdx.x == 0) (void)xb_add(&bar[XB_XCNT(b.x)], 1u);
    return b;
}
__device__ __forceinline__ void xcd_barrier_complete(unsigned* bar, unsigned x, unsigned& nloc, unsigned& nx) {
    const unsigned G = gridDim.x * gridDim.y * gridDim.z;
    unsigned sum, cnt, mine, sp = 0u;
    for (;;) {
        sum = 0u; cnt = 0u; mine = 0u;
#pragma unroll
        for (unsigned j = 0; j < 16; ++j) { const unsigned c = xb_ld(&bar[XB_XCNT(j)]); sum += c; cnt += (c > 0u) ? 1u : 0u; mine = (j == x) ? c : mine; }
        if (sum == G) break;
        __builtin_amdgcn_s_sleep(1);
        if ((++sp & 255u) == 0u) { if (xb_ld(&bar[XB_TMO])) break; if (sp > XB_SPIN_CAP) { atomicAdd(&bar[XB_TMO], 1u); break; } }
    }
    nloc = mine > 0u ? mine : 1u; nx = cnt > 0u ? cnt : 1u;
}

__device__ __forceinline__ void xcd_barrier(const XcdBarrier& b) {
    asm volatile("s_waitcnt vmcnt(0)" ::: "memory");
    __syncthreads();
    if (threadIdx.x == 0) {
        unsigned* bar = b.bar;
        __builtin_amdgcn_s_waitcnt(0);
        unsigned nloc = b.st[0], nx = b.st[1];
        if (nloc == 0u) { xcd_barrier_complete(bar, b.x, nloc, nx); b.st[0] = nloc; b.st[1] = nx; }
        const unsigned old = xb_add(&bar[XB_XSUB(b.x)], 1u);
        const unsigned gen = old / nloc;
        if (old + 1u == (gen + 1u) * nloc) {
            __builtin_amdgcn_fence(__ATOMIC_RELEASE, "agent");
            asm volatile("s_waitcnt vmcnt(0)" ::: "memory");
            const unsigned og = xb_add(&bar[XB_TOP], 1u);
            const unsigned tg = og / nx;
            if (og + 1u == (tg + 1u) * nx) xb_add(&bar[XB_TOPGEN], 1u);
            else XB_SPIN(xb_ld(&bar[XB_TOPGEN]) == tg, bar);
            __builtin_amdgcn_fence(__ATOMIC_ACQUIRE, "agent");
            xb_add(&bar[XB_XGEN(b.x)], 1u);
            asm volatile("s_waitcnt vmcnt(0)" ::: "memory");
        } else {
            XB_SPIN(xb_ld(&bar[XB_XGEN(b.x)]) == gen, bar);
            __builtin_amdgcn_fence(__ATOMIC_ACQUIRE, "agent");
            asm volatile("s_waitcnt vmcnt(0)" ::: "memory");
        }
    }
    __syncthreads();
}

__device__ __forceinline__ void xcd_barrier_arrive(const XcdBarrier& b, volatile LAS unsigned* mb) {
    asm volatile("s_waitcnt vmcnt(0)" ::: "memory");
    __syncthreads();
    if (threadIdx.x == 0) {
        unsigned* bar = b.bar;
        __builtin_amdgcn_s_waitcnt(0);
        unsigned nloc = b.st[0], nx = b.st[1];
        if (nloc == 0u) { xcd_barrier_complete(bar, b.x, nloc, nx); b.st[0] = nloc; b.st[1] = nx; }
        const unsigned old = xb_add(&bar[XB_XSUB(b.x)], 1u);
        const unsigned gen = old / nloc;
        if (old + 1u == (gen + 1u) * nloc) {
            __builtin_amdgcn_fence(__ATOMIC_RELEASE, "agent");
            asm volatile("s_waitcnt vmcnt(0)" ::: "memory");
            const unsigned og = xb_add(&bar[XB_TOP], 1u);
            const unsigned tg = og / nx;
            if (og + 1u == (tg + 1u) * nx) xb_add(&bar[XB_TOPGEN], 1u);
            else XB_SPIN(xb_ld(&bar[XB_TOPGEN]) == tg, bar);
            __builtin_amdgcn_fence(__ATOMIC_ACQUIRE, "agent");
            xb_add(&bar[XB_XGEN(b.x)], 1u);
            asm volatile("s_waitcnt vmcnt(0)" ::: "memory");
            mb[0] = 0u;
        } else { mb[0] = 1u; mb[1] = gen; }
    }
    asm volatile("s_waitcnt lgkmcnt(0)" ::: "memory"); __syncthreads();
}
__device__ __forceinline__ unsigned xcd_released(const XcdBarrier& b, unsigned gen) { return (xb_ld(&b.bar[XB_XGEN(b.x)]) != gen) ? 1u : 0u; }
__device__ __forceinline__ void xcd_wait_release(const XcdBarrier& b, unsigned gen) { XB_SPIN(xb_ld(&b.bar[XB_XGEN(b.x)]) == gen, b.bar); }
__device__ __forceinline__ void xcd_acquire() { __builtin_amdgcn_fence(__ATOMIC_ACQUIRE, "agent"); asm volatile("s_waitcnt vmcnt(0)" ::: "memory"); }

struct Args { const float* in[19]; float* out; unsigned char* ws; int ph_lo, ph_hi; };
static_assert(sizeof(Args) == 19 * 8 + 8 + 8 + 8, "Args has no padding");

__device__ __forceinline__ float wave_sum(float v) {
#pragma unroll
    for (int o = 1; o < 64; o <<= 1) v += __shfl_xor(v, o);
    return v;
}

template <int DEEP = 0>
__device__ __forceinline__ void tr_item(const float* W, int N, bf16* WT, int ldk, int kofs, int rowbase, LAS float* scr, int kb, int nb, int lane, const float* gain = nullptr) {
    const float* src = W + (size_t)(64 * kb) * N + 64 * nb + lane;
    const int c = lane & 7;
    f32x4 ga = (f32x4){1.f, 1.f, 1.f, 1.f}, gb = ga;
    if (gain) { ga = *(const GAS f32x4*)(gain + 64 * kb + 8 * c); gb = *(const GAS f32x4*)(gain + 64 * kb + 8 * c + 4); }
    if (DEEP) { float v[64];
#pragma unroll
        for (int kk = 0; kk < 64; ++kk) v[kk] = __builtin_nontemporal_load(src + (size_t)kk * N);
#pragma unroll
        for (int kk = 0; kk < 64; ++kk) scr[kk * 65 + lane] = v[kk];
    } else {
#pragma unroll 16
        for (int kk = 0; kk < 64; ++kk) scr[kk * 65 + lane] = __builtin_nontemporal_load(src + (size_t)kk * N);
    }
    LDS_WAIT(); asm volatile("" ::: "memory");
#pragma unroll
    for (int j = 0; j < 8; ++j) { const int n = (lane >> 3) + 8 * j; const LAS float* s = scr + (8 * c) * 65 + n;
        v4u o; o.x = cvtpk_c(s[0 * 65] * ga[0], s[1 * 65] * ga[1]); o.y = cvtpk_c(s[2 * 65] * ga[2], s[3 * 65] * ga[3]); o.z = cvtpk_c(s[4 * 65] * gb[0], s[5 * 65] * gb[1]); o.w = cvtpk_c(s[6 * 65] * gb[2], s[7 * 65] * gb[3]);
        if (DEEP) __builtin_nontemporal_store(o, (GAS v4u*)(WT + (size_t)(rowbase + n) * ldk + kofs + 64 * kb + 8 * c)); else *(GAS v4u*)(WT + (size_t)(rowbase + n) * ldk + kofs + 64 * kb + 8 * c) = o; }
    LDS_WAIT(); asm volatile("" ::: "memory");
}
__device__ __forceinline__ void cvt_row_bf16(const float* xrow, bf16* orow, float* ss, int lane) {
    const GAS f32x4* xr = (const GAS f32x4*)xrow + lane;
    f32x4 v[16]; float s = 0.f;
#pragma unroll
    for (int j = 0; j < 16; ++j) { v[j] = __builtin_nontemporal_load(xr + 64 * j); s += (v[j].x * v[j].x + v[j].y * v[j].y) + (v[j].z * v[j].z + v[j].w * v[j].w); }
    s = wave_sum(s);
    GAS v2u* o8 = (GAS v2u*)orow + lane;
#pragma unroll
    for (int j = 0; j < 16; ++j) { v2u w; w.x = cvtpk(v[j].x, v[j].y); w.y = cvtpk(v[j].z, v[j].w); o8[64 * j] = w; }
    if (lane == 0) *ss = s;
}
__device__ __forceinline__ void rms_row_out(const bf16* hrow, float* orow, const float* gain, int lane) {
    const GAS v4u* hr = (const GAS v4u*)hrow + lane; const GAS f32x4* gr = (const GAS f32x4*)gain; GAS f32x4* o4 = (GAS f32x4*)orow;
    v4u w[8]; float s = 0.f;
#pragma unroll
    for (int j = 0; j < 8; ++j) { w[j] = hr[64 * j];
        const float a0 = __uint_as_float(w[j].x << 16), a1 = __uint_as_float(w[j].x & 0xffff0000u), a2 = __uint_as_float(w[j].y << 16), a3 = __uint_as_float(w[j].y & 0xffff0000u);
        const float a4 = __uint_as_float(w[j].z << 16), a5 = __uint_as_float(w[j].z & 0xffff0000u), a6 = __uint_as_float(w[j].w << 16), a7 = __uint_as_float(w[j].w & 0xffff0000u);
        s += (a0 * a0 + a1 * a1) + (a2 * a2 + a3 * a3) + (a4 * a4 + a5 * a5) + (a6 * a6 + a7 * a7); }
    const float rstd = 1.0f / sqrtf(wave_sum(s) * (1.f / DM) + RMS_EPS);
#pragma unroll
    for (int j = 0; j < 8; ++j) { const int e = (64 * j + lane) * 2;
        const f32x4 g0 = gr[e], g1 = gr[e + 1]; f32x4 o0, o1;
        o0[0] = __uint_as_float(w[j].x << 16) * rstd * g0[0]; o0[1] = __uint_as_float(w[j].x & 0xffff0000u) * rstd * g0[1]; o0[2] = __uint_as_float(w[j].y << 16) * rstd * g0[2]; o0[3] = __uint_as_float(w[j].y & 0xffff0000u) * rstd * g0[3];
        o1[0] = __uint_as_float(w[j].z << 16) * rstd * g1[0]; o1[1] = __uint_as_float(w[j].z & 0xffff0000u) * rstd * g1[1]; o1[2] = __uint_as_float(w[j].w << 16) * rstd * g1[2]; o1[3] = __uint_as_float(w[j].w & 0xffff0000u) * rstd * g1[3];
        o4[e] = o0; o4[e + 1] = o1; }
}

namespace att {
constexpr int LD = 2 * HD, LDO = DM;
constexpr int SHM_V = 16384, SHM_K = 16384;
constexpr int NSLOT = 3, OFF_V = 0, OFF_K = NSLOT * SHM_V, OFF_WS = NSLOT * (SHM_V + SHM_K), OFF_FLAG = OFF_WS + NWAVES * 256, OFF_KMS = OFF_FLAG + 64;
#define KSWZ(row, colB) ((row) * 256 + ((colB) ^ (((row) & 7) << 4)))
__device__ __forceinline__ int v_st(int k, int c) { const int kk = (k & ~0xC) | ((k & 4) << 1) | ((k & 8) >> 1); return ((kk >> 3) * 4 + (c >> 5)) * 512 + ((kk & 7) * 32 + (c & 31)) * 2; }
__device__ __forceinline__ int v_rd_base(int lane) { return ((lane & 3) << 3) | (((lane >> 2) & 3) << 6) | (((lane >> 4) & 1) << 5) | (((lane >> 5) & 1) << 8); }
constexpr int v_rd_off(int d0, int ks, int half) { return d0 * 512 + ks * 4096 + half * 2048; }
__device__ __forceinline__ int crow(int r, int hi) { return (r & 3) + 8 * (r >> 2) + 4 * hi; }
__device__ __forceinline__ float pmaxswap(float v) { auto rr = __builtin_amdgcn_permlane32_swap(__float_as_uint(v), __float_as_uint(v), false, false); return fmaxf(__uint_as_float(rr[0]), __uint_as_float(rr[1])); }
__device__ __forceinline__ float psumswap(float v) { auto rr = __builtin_amdgcn_permlane32_swap(__float_as_uint(v), __float_as_uint(v), false, false); return __uint_as_float(rr[0]) + __uint_as_float(rr[1]); }

__device__ __forceinline__ void qkt(f32x16& p0, f32x16& p1, LAS const char* Kbuf, int r32, int hi, const bf16x8* qr) {
    p0 = f32x16{}; p1 = f32x16{};
    LAS const char* kb[4];
#pragma unroll
    for (int dd = 0; dd < 4; ++dd) kb[dd] = Kbuf + KSWZ(r32, (dd * 16 + hi * 8) * 2);
#pragma unroll
    for (int d0 = 0; d0 < 8; ++d0) { LAS const char* a = kb[d0 & 3] + (d0 >> 2) * 128;
        const bf16x8 b0 = *(LAS const bf16x8*)a; const bf16x8 b1 = *(LAS const bf16x8*)(a + 32 * 256);
        p0 = __builtin_amdgcn_mfma_f32_32x32x16_bf16(b0, qr[d0], p0, 0, 0, 0);
        p1 = __builtin_amdgcn_mfma_f32_32x32x16_bf16(b1, qr[d0], p1, 0, 0, 0); }
}
__device__ __forceinline__ void pv_tile(f32x16* o, int vb, bf16x8 pa0, bf16x8 pa1, bf16x8 pa2, bf16x8 pa3) {
#define TRRD(dst, off) asm volatile("ds_read_b64_tr_b16 %0, %1 offset:%2" : "=&v"(dst) : "v"(vb), "i"(off) : "memory")
#define PV_RD(S, d0) do { constexpr int b_ = v_rd_off(d0, 0, 0); \
        TRRD(S##l0, b_); TRRD(S##h0, b_ + 2048); TRRD(S##l1, b_ + 4096); TRRD(S##h1, b_ + 6144); TRRD(S##l2, b_ + 8192); TRRD(S##h2, b_ + 10240); TRRD(S##l3, b_ + 12288); TRRD(S##h3, b_ + 14336); } while (0)
#define PV_MM(S, d0) do { \
        o[d0] = __builtin_amdgcn_mfma_f32_32x32x16_bf16(pa0, (bf16x8){S##l0[0], S##l0[1], S##l0[2], S##l0[3], S##h0[0], S##h0[1], S##h0[2], S##h0[3]}, o[d0], 0, 0, 0); \
        o[d0] = __builtin_amdgcn_mfma_f32_32x32x16_bf16(pa1, (bf16x8){S##l1[0], S##l1[1], S##l1[2], S##l1[3], S##h1[0], S##h1[1], S##h1[2], S##h1[3]}, o[d0], 0, 0, 0); \
        o[d0] = __builtin_amdgcn_mfma_f32_32x32x16_bf16(pa2, (bf16x8){S##l2[0], S##l2[1], S##l2[2], S##l2[3], S##h2[0], S##h2[1], S##h2[2], S##h2[3]}, o[d0], 0, 0, 0); \
        o[d0] = __builtin_amdgcn_mfma_f32_32x32x16_bf16(pa3, (bf16x8){S##l3[0], S##l3[1], S##l3[2], S##l3[3], S##h3[0], S##h3[1], S##h3[2], S##h3[3]}, o[d0], 0, 0, 0); } while (0)
    s16x4 Al0, Al1, Al2, Al3, Ah0, Ah1, Ah2, Ah3, Bl0, Bl1, Bl2, Bl3, Bh0, Bh1, Bh2, Bh3;
    PV_RD(A, 0);
    PV_RD(B, 1); asm volatile("s_waitcnt lgkmcnt(8)" ::: "memory"); SBAR(); PV_MM(A, 0); SBAR();
    PV_RD(A, 2); asm volatile("s_waitcnt lgkmcnt(8)" ::: "memory"); SBAR(); PV_MM(B, 1); SBAR();
    PV_RD(B, 3); asm volatile("s_waitcnt lgkmcnt(8)" ::: "memory"); SBAR(); PV_MM(A, 2); SBAR();
    asm volatile("s_waitcnt lgkmcnt(0)" ::: "memory"); SBAR(); PV_MM(B, 3);
#undef PV_MM
#undef PV_RD
#undef TRRD
}
__device__ __forceinline__ void pack_p(const f32x16& p0, const f32x16& p1, bf16x8& pa0, bf16x8& pa1, bf16x8& pa2, bf16x8& pa3) {
#define PK4(P, B_, OUT) do { unsigned a0 = cvtpk(P[B_+0], P[B_+1]), a1 = cvtpk(P[B_+2], P[B_+3]); \
        unsigned b0 = cvtpk(P[B_+4], P[B_+5]), b1 = cvtpk(P[B_+6], P[B_+7]); \
        auto r0 = __builtin_amdgcn_permlane32_swap(a0, b0, false, false); auto r1 = __builtin_amdgcn_permlane32_swap(a1, b1, false, false); \
        v4u w = {r0[0], r1[0], r0[1], r1[1]}; OUT = *reinterpret_cast<bf16x8*>(&w); } while (0)
    PK4(p0, 0, pa0); PK4(p0, 8, pa1); PK4(p1, 0, pa2); PK4(p1, 8, pa3);
#undef PK4
}

template <int MODE>
__device__ __forceinline__ void attn_unit(const bf16* Qg, const bf16* Kg, const bf16* Vg, bf16* Og, int qb, float slope, const float* KMg, const float* KNg, LAS char* lds) {
    const int tid = threadIdx.x, wid = __builtin_amdgcn_readfirstlane(tid >> 6), lane = tid & 63, r32 = lane & 31, hi = lane >> 5;
    const int t0 = qb * 256 + wid * 32, trow = t0 + r32;
    LAS float* wsf = (LAS float*)(lds + OFF_WS) + wid * 64; LAS float* li_l = wsf;
    volatile LAS int* flags = (volatile LAS int*)(lds + OFF_FLAG);
    const int vb0 = (int)(size_t)(lds + OFF_V) + v_rd_base(lane);
    constexpr float LOG2E = 1.4426950408889634f, SCALE = 0.08838834764831845f, C2 = LOG2E * SCALE;
    bf16x8 qr[8];
#pragma unroll
    for (int d0 = 0; d0 < 8; ++d0) qr[d0] = *(const GAS bf16x8*)(Qg + (size_t)trow * LD + d0 * 16 + hi * 8);
    unsigned selmask = 0u;
    if (MODE == 0) {
        if (qb <= 3) selmask = (1u << qb) - 1u;
        else {
            const int nrow = (r32 & 3) + 4 * (r32 >> 3);
            f32x16 g = f32x16{};
#pragma unroll
            for (int d0 = 0; d0 < 8; ++d0) {
                f32x4 a = (f32x4){0.f, 0.f, 0.f, 0.f}, b = a;
                if (nrow < qb) { const GAS f32x4* kp = (const GAS f32x4*)(KMg + nrow * HD + d0 * 16 + hi * 8); a = kp[0]; b = kp[1]; }
                v4u whi, wlo;
                whi.x = cvtpk(a[0], a[1]); whi.y = cvtpk(a[2], a[3]); whi.z = cvtpk(b[0], b[1]); whi.w = cvtpk(b[2], b[3]);
                wlo.x = cvtpk(a[0] - __uint_as_float(whi.x << 16), a[1] - __uint_as_float(whi.x & 0xffff0000u)); wlo.y = cvtpk(a[2] - __uint_as_float(whi.y << 16), a[3] - __uint_as_float(whi.y & 0xffff0000u));
                wlo.z = cvtpk(b[0] - __uint_as_float(whi.z << 16), b[1] - __uint_as_float(whi.z & 0xffff0000u)); wlo.w = cvtpk(b[2] - __uint_as_float(whi.w << 16), b[3] - __uint_as_float(whi.w & 0xffff0000u));
                g = __builtin_amdgcn_mfma_f32_32x32x16_bf16(*reinterpret_cast<bf16x8*>(&whi), qr[d0], g, 0, 0, 0);
                g = __builtin_amdgcn_mfma_f32_32x32x16_bf16(*reinterpret_cast<bf16x8*>(&wlo), qr[d0], g, 0, 0, 0);
            }
#pragma unroll
            for (int pick = 0; pick < 3; ++pick) { float best = -__builtin_inff(); int bi = -1;
#pragma unroll
                for (int n = 0; n < 16; ++n) { const bool cand = (n < qb) && !((selmask >> n) & 1u); if (cand && (bi < 0 || g[n] > best)) { best = g[n]; bi = n; } }
                if (bi >= 0) selmask |= 1u << bi; }
        }
    }
    const float sl2 = slope * LOG2E;
    float mrow = 0.f, mrow_w = 0.f;
    if (MODE == 0) {
        float qn = 0.f;
#pragma unroll
        for (int d0 = 0; d0 < 8; ++d0)
#pragma unroll
            for (int j = 0; j < 8; ++j) { const float v = __uint_as_float(((unsigned)(unsigned short)qr[d0][j]) << 16); qn += v * v; }
        qn = psumswap(qn);
        float kn = 0.f;
        for (int n = 0; n <= qb; ++n) kn = fmaxf(kn, KNg[n]);
        mrow = C2 * sqrtf(qn) * sqrtf(kn) * 1.001f;
        mrow_w = mrow;
#pragma unroll
        for (int o_ = 1; o_ < 64; o_ <<= 1) mrow_w = fmaxf(mrow_w, __shfl_xor(mrow_w, o_));
    }
    float l_reg = 0.f, carry = 0.f; f32x16 o[4] = {};
    bool done = false;
    const int NT = 4 * (qb + 1);
    int gofK[2], gofV[2];
#pragma unroll
    for (int i = 0; i < 2; ++i) { const int pi = wid * 2 + i;
        { const int row = pi * 4 + (lane >> 4), colB = (16 * (lane & 15)) ^ ((row & 7) << 4); gofK[i] = row * LD + (colB >> 1); }
        { const int sub = 2 * pi + (lane >> 5), kk = (sub >> 2) * 8 + ((lane & 31) >> 2), c = (sub & 3) * 32 + 8 * (lane & 3), k = (kk & ~0xC) | ((kk & 4) << 1) | ((kk & 8) >> 1); gofV[i] = k * LD + c; } }
#define TDMA(jt_) do { const int sl_ = (jt_) % NSLOT; const bf16* kt_ = Kg + (size_t)(jt_) * 64 * LD; const bf16* vt_ = Vg + (size_t)(jt_) * 64 * LD; \
        _Pragma("unroll") for (int i_ = 0; i_ < 2; ++i_) { \
            __builtin_amdgcn_global_load_lds((const unsigned*)(kt_ + gofK[i_]), (LAS unsigned*)(lds + OFF_K + sl_ * SHM_K + (wid * 2 + i_) * 1024), 16, 0, 0); \
            __builtin_amdgcn_global_load_lds((const unsigned*)(vt_ + gofV[i_]), (LAS unsigned*)(lds + OFF_V + sl_ * SHM_V + (wid * 2 + i_) * 1024), 16, 0, 0); } } while (0)
    TDMA(NT - 1); TDMA(NT - 2);
    asm volatile("s_waitcnt vmcnt(4)" ::: "memory");
    __builtin_amdgcn_s_barrier(); asm volatile("" ::: "memory");
    for (int jt = NT - 1; jt >= 0; --jt) {
        const int buf = jt % NSLOT;
        if (jt >= 2) TDMA(jt - 2);
        const int kb = jt * 64;
        bool act = (kb <= t0 + 31) && !done;
        const int nblk = jt >> 2;
        if (MODE == 0 && nblk < qb) act = act && __any((selmask >> nblk) & 1u);
        if (act) {
            f32x16 p0, p1;
            qkt(p0, p1, (LAS const char*)(lds + OFF_K + buf * SHM_K), r32, hi, qr);
            const int dq = trow - kb - 4 * hi;
            if (MODE == 0) {
                const bool sel = (nblk >= qb) || ((selmask >> nblk) & 1u);
                const float A0 = sel ? (-sl2 * (float)dq - mrow) : -__builtin_inff();
#pragma unroll
                for (int r = 0; r < 16; ++r) { const int c = (r & 3) + 8 * (r >> 2); const float B = A0 + sl2 * (float)c; p0[r] = fmaf(p0[r], C2, B); p1[r] = fmaf(p1[r], C2, B + 32.f * sl2); }
                if (kb + 63 > t0) {
#pragma unroll
                    for (int r = 0; r < 16; ++r) { const int c = (r & 3) + 8 * (r >> 2); if (c > dq) p0[r] = -__builtin_inff(); if (c + 32 > dq) p1[r] = -__builtin_inff(); }
                }
                float ps = 0.f;
#pragma unroll
                for (int r = 0; r < 16; ++r) { p0[r] = __builtin_amdgcn_exp2f(p0[r]); ps += p0[r]; }
#pragma unroll
                for (int r = 0; r < 16; ++r) { p1[r] = __builtin_amdgcn_exp2f(p1[r]); ps += p1[r]; }
                l_reg += psumswap(ps);
            } else {
                f32x16 k0, k1;
#pragma unroll
                for (int r = 0; r < 16; ++r) { const int c = (r & 3) + 8 * (r >> 2);
                    { const float z2 = p0[r] * C2; const float sp = fmaxf(z2, 0.f) + __builtin_amdgcn_logf(1.0f + __builtin_amdgcn_exp2f(-fabsf(z2))); const bool v = c < dq; k0[r] = v ? -sp : 0.f; p0[r] = v ? z2 - sp : -__builtin_inff(); }
                    { const float z2 = p1[r] * C2; const float sp = fmaxf(z2, 0.f) + __builtin_amdgcn_logf(1.0f + __builtin_amdgcn_exp2f(-fabsf(z2))); const bool v = c + 32 < dq; k1[r] = v ? -sp : 0.f; p1[r] = v ? z2 - sp : -__builtin_inff(); } }
                float T0[4], T1[4];
#pragma unroll
                for (int g = 0; g < 4; ++g) {
                    { const float a3 = k0[4 * g + 3], a2 = k0[4 * g + 2], a1 = k0[4 * g + 1], a0 = k0[4 * g]; const float e2 = a3, e1 = e2 + a2, e0 = e1 + a1; T0[g] = e0 + a0; k0[4 * g + 3] = 0.f; k0[4 * g + 2] = e2; k0[4 * g + 1] = e1; k0[4 * g] = e0; }
                    { const float a3 = k1[4 * g + 3], a2 = k1[4 * g + 2], a1 = k1[4 * g + 1], a0 = k1[4 * g]; const float e2 = a3, e1 = e2 + a2, e0 = e1 + a1; T1[g] = e0 + a0; k1[4 * g + 3] = 0.f; k1[4 * g + 2] = e2; k1[4 * g + 1] = e1; k1[4 * g] = e0; }
                }
                float P0[4], P1[4];
#pragma unroll
                for (int g = 0; g < 4; ++g) { P0[g] = __shfl_xor(T0[g], 32); P1[g] = __shfl_xor(T1[g], 32); }
                float R1[4], R0[4];
                R1[3] = 0.f; R1[2] = T1[3] + P1[3]; R1[1] = R1[2] + (T1[2] + P1[2]); R1[0] = R1[1] + (T1[1] + P1[1]); const float tot1 = R1[0] + (T1[0] + P1[0]);
                R0[3] = 0.f; R0[2] = T0[3] + P0[3]; R0[1] = R0[2] + (T0[2] + P0[2]); R0[0] = R0[1] + (T0[1] + P0[1]); const float tot0 = R0[0] + (T0[0] + P0[0]);
#pragma unroll
                for (int g = 0; g < 4; ++g) {
                    const float off1 = carry + R1[g] + (hi == 0 ? P1[g] : 0.f), off0 = carry + tot1 + R0[g] + (hi == 0 ? P0[g] : 0.f);
#pragma unroll
                    for (int i = 0; i < 4; ++i) { p0[4 * g + i] = __builtin_amdgcn_exp2f(p0[4 * g + i] + k0[4 * g + i] + off0); p1[4 * g + i] = __builtin_amdgcn_exp2f(p1[4 * g + i] + k1[4 * g + i] + off1); }
                }
                carry += tot0 + tot1;
                if (__all(carry < -150.1f)) done = true;
            }
            bf16x8 pa0, pa1, pa2, pa3;
            pack_p(p0, p1, pa0, pa1, pa2, pa3);
            pv_tile(o, vb0 + buf * SHM_V, pa0, pa1, pa2, pa3);
        }
        bool stop = false;
        if (MODE == 0 && jt >= 1 && 2.f * mrow_w - sl2 * (float)(t0 - (jt - 1) * 64 - 63) < -150.5f) done = true;
        if (lane == 0) flags[(jt & 1) * 8 + wid] = done ? 1 : 0;
        if (jt >= 2) asm volatile("s_waitcnt vmcnt(4) lgkmcnt(0)" ::: "memory"); else asm volatile("s_waitcnt vmcnt(0) lgkmcnt(0)" ::: "memory");
        __builtin_amdgcn_s_barrier(); asm volatile("" ::: "memory");
        { int all = 1;
#pragma unroll
            for (int w = 0; w < 8; ++w) all &= flags[(jt & 1) * 8 + w];
            stop = (all != 0); }
        if (stop) break;
    }
    asm volatile("s_waitcnt vmcnt(0)" ::: "memory");
#undef TDMA
    float rli[16];
    if (MODE == 0) { if (hi == 0) li_l[r32] = l_reg; LDS_WAIT();
#pragma unroll
        for (int r = 0; r < 16; ++r) rli[r] = __builtin_amdgcn_rcpf(li_l[crow(r, hi)]); }
    bf16* Ow = Og + (size_t)t0 * LDO;
#pragma unroll
    for (int r = 0; r < 16; ++r) { const int orow = crow(r, hi);
#pragma unroll
        for (int d0 = 0; d0 < 4; ++d0) { const float v = (MODE == 0) ? o[d0][r] * rli[r] : o[d0][r];
            *(GAS unsigned short*)(Ow + (size_t)orow * LDO + d0 * 32 + r32) = (unsigned short)cvtpk_c(v, v); } }
    LDS_WAIT();
    __syncthreads();
}
}

__global__ void __launch_bounds__(NWAVES * 64, 2) mega_fwd(Args args) {
    extern __shared__ __attribute__((aligned(16))) unsigned char lds_raw[];
    LAS unsigned char* lds = (LAS unsigned char*)lds_raw;
    volatile LAS unsigned* MISC = (volatile LAS unsigned*)(lds + MISC_OFF);
    const int tid = threadIdx.x, lane = tid & 63, wave = __builtin_amdgcn_readfirstlane(tid >> 6);
    const int G = gridDim.x, bid = blockIdx.x;
    unsigned char* ws = args.ws;
    gu32* ctl = (gu32*)(ws + WS_CTL);
    const float* x = args.in[0]; const float* pin = args.in[1];
    const float* g_ffn1 = args.in[2]; const float* w_g1 = args.in[3]; const float* w_u1 = args.in[4]; const float* w_d1 = args.in[5];
    const float* g_mix = args.in[6]; const float* w_in = args.in[7]; const float* w_bA = args.in[8]; const float* w_bB = args.in[9]; const float* w_out = args.in[10];
    const float* g_ffn2 = args.in[11]; const float* w_g2 = args.in[12]; const float* w_u2 = args.in[13]; const float* w_d2 = args.in[14];
    const float* g_ple = args.in[15]; const float* w_pg = args.in[16]; const float* w_pe = args.in[17]; const float* g_fin = args.in[18];
    float* out = args.out;
    bf16* WGU1 = (bf16*)(ws + WS_WGU1); bf16* WD1 = (bf16*)(ws + WS_WD1); bf16* WIN = (bf16*)(ws + WS_WIN); bf16* WBR = (bf16*)(ws + WS_WBR); bf16* WOUT = (bf16*)(ws + WS_WOUT);
    bf16* WGU2 = (bf16*)(ws + WS_WGU2); bf16* WD2 = (bf16*)(ws + WS_WD2); bf16* WPG = (bf16*)(ws + WS_WPG); bf16* WPE = (bf16*)(ws + WS_WPE);
    bf16* PBF = (bf16*)(ws + WS_PBF); bf16* XB = (bf16*)(ws + WS_XBZ); bf16* Z = XB; bf16* HF = XB;     bf16* HB = (bf16*)(ws + WS_HB); bf16* ATT = (bf16*)(ws + WS_ATT); bf16* PE = (bf16*)args.out;
    bf16* QKV = (bf16*)(ws + WS_R1); bf16* GAB = QKV + (size_t)6 * M * AW; bf16* ACT = (bf16*)(ws + WS_R1);
    float* SS0 = (float*)(ws + WS_SS0); float* SS1 = (float*)(ws + WS_SS1); float* SS2 = (float*)(ws + WS_SS2); float* SS3 = (float*)(ws + WS_SS3);
    float* KM = (float*)(ws + WS_KM); float* KN = (float*)(ws + WS_KM + 512 * 1024);

    for (int u = tid; u < (LDS_BYTES - LDSCTL_OFF) / 4; u += NWAVES * 64) ((LAS unsigned*)(lds + LDSCTL_OFF))[u] = 0u;
    __syncthreads();
    XcdBarrier bar; bar.bar = (unsigned*)(ctl + CW_BAR); bar.x = 0; bar.st = nullptr;
    if (MK_N_LAUNCHES == 1) bar = xcd_barrier_post((unsigned*)(ctl + CW_BAR), MISC + 8);
    const int lo = args.ph_lo, hi = args.ph_hi;
#define IN(k) (lo <= (k) && (k) < hi)
#define SEAM(k) do { if (IN(k) && IN((k) + 1)) xcd_barrier(bar); } while (0)
    const int gw = bid * NWAVES + wave, NGW = G * NWAVES;
    LAS float* rsl = (LAS float*)(lds + LDSCTL_OFF + 1024);
#define PREP_RS(RSV, SSp, S_) pg8::RowScale RSV{SSp, rsl, -1}; do { pg8::Unit u0_; if (S_.next(0, u0_)) { RSV.pm0 = u0_.pm; if (tid < 256) rsl[tid] = __builtin_amdgcn_rsqf(SSp[u0_.pm * 256 + tid] * (1.0f / DM) + RMS_EPS); } LDS_WAIT(); __syncthreads(); } while (0)

    constexpr int I_GU = (DM / 64) * (DFF / 64), I_D = (DFF / 64) * (DM / 64), I_IN = (DM / 64) * (INC / 64), I_BR = (AW / 64) * (DM / 64), I_SQ = (DM / 64) * (DM / 64), I_PE = (PLE / 64) * (DM / 64);
    constexpr int NITEMS = 4 * I_GU + 2 * I_D + I_IN + 2 * I_BR + 2 * I_SQ + I_PE;
    const bool tailfill = (G == 256);
#define CONV_ITEM(it_) do { int r = (it_); LAS float* scr = (LAS float*)(lds + RING_OFF + wave * 16640);     \
        if (r < 4 * I_GU) { const int which = r / I_GU; r -= which * I_GU; const int nbn = DFF / 64, kb = r / nbn, nb = r % nbn; const int n0 = 64 * nb;     \
            const float* W = which == 0 ? w_g1 : which == 1 ? w_u1 : which == 2 ? w_g2 : w_u2; bf16* WT = which < 2 ? WGU1 : WGU2; \
            tr_item(W, DFF, WT, DM, 0, (n0 >> 7) * 256 + (n0 & 127) + (which & 1) * 128, scr, kb, nb, lane, which < 2 ? g_ffn1 : g_ffn2); break; } \
        r -= 4 * I_GU; \
        if (r < 2 * I_D) { const int which = r / I_D; r -= which * I_D; const int nbn = DM / 64, kb = r / nbn, nb = r % nbn; \
            tr_item(which ? w_d2 : w_d1, DM, which ? WD2 : WD1, DFF, 0, 64 * nb, scr, kb, nb, lane); break; } \
        r -= 2 * I_D; \
        if (r < I_IN) { const int nbn = INC / 64, kb = r / nbn, nb = r % nbn; tr_item(w_in, INC, WIN, DM, 0, 64 * nb, scr, kb, nb, lane, g_mix); break; } \
        r -= I_IN; \
        if (r < 2 * I_BR) { const int which = r / I_BR; r -= which * I_BR; const int nbn = DM / 64, kb = r / nbn, nb = r % nbn; \
            tr_item(which ? w_bB : w_bA, DM, WBR, 2 * AW, which * AW, 64 * nb, scr, kb, nb, lane); break; } \
        r -= 2 * I_BR; \
        if (r < 2 * I_SQ) { const int which = r / I_SQ; r -= which * I_SQ; const int nbn = DM / 64, kb = r / nbn, nb = r % nbn; \
            tr_item(which ? w_pg : w_out, DM, which ? WPG : WOUT, DM, 0, 64 * nb, scr, kb, nb, lane, which ? g_ple : nullptr); break; } \
        r -= 2 * I_SQ; \
        { const int nbn = DM / 64, kb = r / nbn, nb = r % nbn; tr_item(w_pe, DM, WPE, PLE, 0, 64 * nb, scr, kb, nb, lane); } } while (0)
    constexpr int N_LATE = I_D + I_IN + 2 * I_BR + I_SQ + 2 * I_GU + I_D + I_SQ, NT_BG = N_LATE / 8, N_EARLY = NITEMS - N_LATE;
    constexpr int T_D1 = I_D / 8, T_IN = T_D1 + I_IN / 8, T_BR = T_IN + 2 * I_BR / 8, T_OUT = T_BR + I_SQ / 8, T_GU2 = T_OUT + 2 * I_GU / 8, T_D2 = T_GU2 + I_D / 8;
    static_assert(N_LATE % 8 == 0 && I_D % 8 == 0 && I_IN % 8 == 0 && (2 * I_BR) % 8 == 0 && I_SQ % 8 == 0, "tickets of 8 tiles, groups on ticket boundaries");
#define BG_CONV(j_) do { int q = (j_); LAS float* scr = (LAS float*)(lds + RING_OFF + wave * 16640); \
        const float* W_; int N_; bf16* WT_; int ldk_, kofs_ = 0, rowbase_, kb_, nb_; const float* gain_ = nullptr; \
        if (q < I_D) { const int nbn = DM / 64; kb_ = q / nbn; nb_ = q % nbn; W_ = w_d1; N_ = DM; WT_ = WD1; ldk_ = DFF; rowbase_ = 64 * nb_; } \
        else if ((q -= I_D) < I_IN) { const int nbn = INC / 64; kb_ = q / nbn; nb_ = q % nbn; W_ = w_in; N_ = INC; WT_ = WIN; ldk_ = DM; rowbase_ = 64 * nb_; gain_ = g_mix; } \
        else if ((q -= I_IN) < 2 * I_BR) { const int which = q / I_BR; q -= which * I_BR; const int nbn = DM / 64; kb_ = q / nbn; nb_ = q % nbn; W_ = which ? w_bB : w_bA; N_ = DM; WT_ = WBR; ldk_ = 2 * AW; kofs_ = which * AW; rowbase_ = 64 * nb_; } \
        else if ((q -= 2 * I_BR) < I_SQ) { const int nbn = DM / 64; kb_ = q / nbn; nb_ = q % nbn; W_ = w_out; N_ = DM; WT_ = WOUT; ldk_ = DM; rowbase_ = 64 * nb_; } \
        else if ((q -= I_SQ) < 2 * I_GU) { const int which = 2 + q / I_GU; q -= (which - 2) * I_GU; const int nbn = DFF / 64; kb_ = q / nbn; nb_ = q % nbn; const int n0 = 64 * nb_;     \
            W_ = which == 2 ? w_g2 : w_u2; N_ = DFF; WT_ = WGU2; ldk_ = DM; rowbase_ = (n0 >> 7) * 256 + (n0 & 127) + (which & 1) * 128; gain_ = g_ffn2; } \
        else if ((q -= 2 * I_GU) < I_D) { const int nbn = DM / 64; kb_ = q / nbn; nb_ = q % nbn; W_ = w_d2; N_ = DM; WT_ = WD2; ldk_ = DFF; rowbase_ = 64 * nb_; } \
        else { q -= I_D; const int nbn = DM / 64; kb_ = q / nbn; nb_ = q % nbn; W_ = w_pg; N_ = DM; WT_ = WPG; ldk_ = DM; rowbase_ = 64 * nb_; gain_ = g_ple; } \
        tr_item<1>(W_, N_, WT_, ldk_, kofs_, rowbase_, scr, kb_, nb_, lane, gain_); } while (0)
#define TRY_BG(more_) do { if (tid == 0) MISC[17] = __hip_atomic_fetch_add(ctl + CW_BG, 1u, RLX_AGENT);     \
        LDS_WAIT(); __syncthreads(); const unsigned t_ = MISC[17]; __syncthreads(); \
        more_ = t_ < (unsigned)NT_BG; if (more_) BG_CONV((int)t_ * 8 + wave); } while (0)
#define DRAIN_BG(T_) do { for (;;) { if (tid == 0) { const unsigned c_ = __hip_atomic_load(ctl + CW_BG, RLX_AGENT); MISC[17] = (c_ >= (unsigned)(T_)) ? 0xffffffffu : __hip_atomic_fetch_add(ctl + CW_BG, 1u, RLX_AGENT); } \
        LDS_WAIT(); __syncthreads(); const unsigned t_ = MISC[17]; __syncthreads(); if (t_ >= (unsigned)NT_BG) break; BG_CONV((int)t_ * 8 + wave); if (t_ >= (unsigned)(T_)) break; } } while (0)
#define SEAM_BG(k) do { if (IN(k) && IN((k) + 1)) { if (MK_N_LAUNCHES != 1) { xcd_barrier(bar); break; } \
        xcd_barrier_arrive(bar, MISC + 18); \
        if (MISC[18] != 0u) { const unsigned gen_ = MISC[19]; \
            for (;;) { if (tid == 0) MISC[20] = xcd_released(bar, gen_); LDS_WAIT(); __syncthreads(); const unsigned rel_ = MISC[20]; __syncthreads(); if (rel_) break; \
                bool more_; TRY_BG(more_); if (!more_) { if (tid == 0) xcd_wait_release(bar, gen_); break; } } \
            if (tid == 0) xcd_acquire(); } \
        __syncthreads(); } } while (0)
    if (IN(0)) {
#pragma unroll 1
        for (int it = gw; it < N_EARLY; it += NGW) { int e = N_EARLY - 1 - it, ridx;
            if (e < 2 * I_GU) ridx = e; else ridx = 4 * I_GU + 2 * I_D + I_IN + 2 * I_BR + 2 * I_SQ + (e - 2 * I_GU);
            CONV_ITEM(ridx); }
        for (int m = gw; m < M; m += NGW) cvt_row_bf16(x + (size_t)m * DM, XB + (size_t)m * DM, SS0 + m, lane);
        for (int i = bid * 512 + tid; i < M * PLE / 8; i += G * 512) { const GAS f32x4* s = (const GAS f32x4*)pin + 2 * (size_t)i; const f32x4 a = s[0], b = s[1];
            v4u w; w.x = cvtpk(a.x, a.y); w.y = cvtpk(a.z, a.w); w.z = cvtpk(b.x, b.y); w.w = cvtpk(b.z, b.w); ((GAS v4u*)PBF)[i] = w; }
    }
    SEAM(0);
    if (IN(1)) {
        pg8::Gemm g{XB, WGU1, M, 2 * DFF, DM, DM, DM}; pg8::StaticOrder S; S.init(M, 2 * DFF, G, bid, WGM_ALL);
        PREP_RS(RS, SS0, S); pg8::EpiSwiGLU E{ACT, DFF, RS};
        pg8::gemm_phase<pg8::EpiSwiGLU, pg8::StaticOrder, PG8_ALIGN, PG8_SP2>(lds + RING_OFF, g, S, E);
        if (tailfill && bid >= 128) {
            pg8::Gemm gp{PBF, WPE, M, DM, PLE, PLE, PLE}; pg8::StaticOrder Sp; Sp.init(M, DM, 128, bid - 128, WGM_ALL); Sp.Lend = 512;
            pg8::EpiBf16 Ep{PE, DM, pg8::RowScale{nullptr, rsl, -1}, 256, 1 << 30, nullptr, 0};
            pg8::gemm_phase<pg8::EpiBf16, pg8::StaticOrder, PG8_ALIGN, PG8_SP2>(lds + RING_OFF, gp, Sp, Ep);
        }
    }
    if (IN(1)) DRAIN_BG(T_D1);
    SEAM_BG(1);
    if (IN(2)) {
        pg8::Gemm g{ACT, WD1, M, DM, DFF, DFF, DFF}; g.krev = 1; pg8::StaticOrder S; S.init(M, DM, G, bid, WGM_DOWN);
        pg8::EpiResidBf E{XB, HB, DM, 0.5f, SS1};
        pg8::gemm_phase<pg8::EpiResidBf, pg8::StaticOrder, PG8_ALIGN, PG8_SP2>(lds + RING_OFF, g, S, E);
    }
    if (IN(2)) DRAIN_BG(T_IN);
    SEAM_BG(2);
    if (IN(3)) {
        pg8::Gemm g{HB, WIN, M, INC, DM, DM, DM}; pg8::StaticOrder S; S.init(M, INC, G, bid, WGM_ALL);
        PREP_RS(RS, SS1, S); pg8::EpiBf16 E{QKV, 2 * HD, RS, (size_t)M * 2 * HD, 48, GAB, 2 * DM};
        pg8::gemm_phase<pg8::EpiBf16, pg8::StaticOrder, PG8_ALIGN, PG8_SP2>(lds + RING_OFF, g, S, E);
    }
    SEAM_BG(3);
    if (IN(4)) {
        LAS float* part = (LAS float*)(lds + RING_OFF);
        for (int u = bid; u < BATCH * NH * NBLK; u += G) {
            const int bh = u / NBLK, n = u % NBLK, b = bh / NH, h = bh % NH;
            const bf16* KAh = QKV + ((size_t)(1 * 8 + (h >> 1)) * M + (size_t)b * SEQ) * 2 * HD + (h & 1) * HD;
            const bf16* kp = KAh + (size_t)(n * MB + wave * 32) * 2 * HD + 2 * lane;
            float s0 = 0.f, s1 = 0.f;
#pragma unroll 8
            for (int r = 0; r < 32; ++r) { const unsigned w = *(const GAS unsigned*)(kp + (size_t)r * 2 * HD); s0 += __uint_as_float(w << 16); s1 += __uint_as_float(w & 0xffff0000u); }
            part[wave * 128 + 2 * lane] = s0; part[wave * 128 + 2 * lane + 1] = s1;
            { const bf16* rp = KAh + (size_t)(n * MB + wave * 32 + (lane >> 1)) * 2 * HD + (lane & 1) * 64; float q2 = 0.f;
#pragma unroll
              for (int j = 0; j < 8; ++j) { const v4u w4 = *(const GAS v4u*)(rp + 8 * j);
                  q2 += __uint_as_float(w4.x << 16) * __uint_as_float(w4.x << 16) + __uint_as_float(w4.x & 0xffff0000u) * __uint_as_float(w4.x & 0xffff0000u);
                  q2 += __uint_as_float(w4.y << 16) * __uint_as_float(w4.y << 16) + __uint_as_float(w4.y & 0xffff0000u) * __uint_as_float(w4.y & 0xffff0000u);
                  q2 += __uint_as_float(w4.z << 16) * __uint_as_float(w4.z << 16) + __uint_as_float(w4.z & 0xffff0000u) * __uint_as_float(w4.z & 0xffff0000u);
                  q2 += __uint_as_float(w4.w << 16) * __uint_as_float(w4.w << 16) + __uint_as_float(w4.w & 0xffff0000u) * __uint_as_float(w4.w & 0xffff0000u); }
              q2 += __shfl_xor(q2, 1);
#pragma unroll
              for (int o_ = 2; o_ < 64; o_ <<= 1) q2 = fmaxf(q2, __shfl_xor(q2, o_));
              if (lane == 0) part[1024 + wave] = q2; }
            LDS_WAIT(); __syncthreads();
            if (tid < 128) { float s = 0.f;
#pragma unroll
                for (int w = 0; w < 8; ++w) s += part[w * 128 + tid];
                KM[(size_t)u * HD + tid] = s * (1.0f / MB); }
            if (tid == 128) { float q2 = part[1024];
#pragma unroll
                for (int w = 1; w < 8; ++w) q2 = fmaxf(q2, part[1024 + w]);
                KN[u] = q2; }
            LDS_WAIT(); __syncthreads();
        }
    }
    SEAM_BG(4);
    if (IN(5)) {
        const bool x8 = (G & 7) == 0; const int grp = x8 ? (bid & 7) : 0, ngrp = x8 ? 8 : 1;
        const int nmo = 512 / ngrp, nsb = 1024 / ngrp;
        gu32* qhead = ctl + CW_QUEUE + 64 * grp;
#pragma unroll 1
        for (;;) {
            if (tid == 0) MISC[16] = __hip_atomic_fetch_add(qhead, 1u, RLX_AGENT);
            LDS_WAIT(); __syncthreads();
            const int i = (int)MISC[16];
            __syncthreads();
            if (i >= nmo) break;
            const int pr = i & 7, kk = i >> 3, bh = x8 ? (grp >> 1) * NH + ((grp & 1) + 2 * (7 - kk)) : 63 - kk, b = bh / NH, h = bh % NH;
            const float slope = exp2f(-0.5f * (float)(h + 1));
            const bf16* base = QKV + ((size_t)(h >> 1) * M + (size_t)b * SEQ) * 2 * HD + (h & 1) * HD;
#pragma unroll 1
            for (int pass = 0; pass < 2; ++pass) { const int qb = pass ? pr : 15 - pr;
                att::attn_unit<0>(base, base + (size_t)1 * M * AW, base + (size_t)2 * M * AW, ATT + (size_t)b * SEQ * DM + h * HD, qb, slope, KM + (size_t)bh * NBLK * HD, KN + bh * NBLK, (LAS char*)(lds + RING_OFF)); }
        }
#pragma unroll 1
        for (;;) {
            if (tid == 0) MISC[16] = __hip_atomic_fetch_add(qhead + 64 * 8, 1u, RLX_AGENT);
            LDS_WAIT(); __syncthreads();
            const int j = (int)MISC[16];
            __syncthreads();
            if (j >= nsb) break;
            const int bh = (x8 ? grp * 8 : 0) + (j >> 4), qb = j & 15, b = bh / NH, h = bh % NH;
            const bf16* base = QKV + ((size_t)(h >> 1) * M + (size_t)b * SEQ) * 2 * HD + (h & 1) * HD;
            att::attn_unit<1>(base + (size_t)3 * M * AW, base + (size_t)4 * M * AW, base + (size_t)5 * M * AW, ATT + (size_t)b * SEQ * DM + AW + h * HD, qb, 0.f, nullptr, nullptr, (LAS char*)(lds + RING_OFF));
        }
    }
    if (IN(5)) DRAIN_BG(T_BR);
    SEAM_BG(5);
    if (IN(6)) {
        { pg8::Gemm g{ATT, WBR, M, DM, AW, DM, 2 * AW}; pg8::StaticOrder S; S.init(M, DM, G, bid, WGM_ALL);
          pg8::EpiGate<false> E{GAB, 2 * DM, Z, DM};
          pg8::gemm_phase<pg8::EpiGate<false>, pg8::StaticOrder, PG8_ALIGN, PG8_SP2>(lds + RING_OFF, g, S, E); }
        { pg8::Gemm g{ATT + AW, WBR + AW, M, DM, AW, DM, 2 * AW}; pg8::StaticOrder S; S.init(M, DM, G, bid, WGM_ALL);
          pg8::EpiGate<true> E{GAB + DM, 2 * DM, Z, DM};
          pg8::gemm_phase<pg8::EpiGate<true>, pg8::StaticOrder, PG8_ALIGN, PG8_SP2>(lds + RING_OFF, g, S, E); }
    }
    if (IN(6)) DRAIN_BG(T_OUT);
    SEAM_BG(6);
    if (IN(7)) {
        { pg8::Gemm g{Z, WOUT, M, DM, DM, DM, DM}; pg8::StaticOrder S; S.init(M, DM, G, bid, WGM_ALL);
          pg8::EpiResidBf E{HB, HB, DM, 1.0f, SS2};
          pg8::gemm_phase<pg8::EpiResidBf, pg8::StaticOrder, PG8_ALIGN, PG8_SP2>(lds + RING_OFF, g, S, E); }
    }
    if (IN(7)) DRAIN_BG(T_GU2);
    SEAM_BG(7);
    if (IN(8)) {
        if (!tailfill) { pg8::Gemm g{PBF, WPE, M, DM, PLE, PLE, PLE}; pg8::StaticOrder S; S.init(M, DM, G, bid, WGM_ALL);
          pg8::EpiBf16 E{PE, DM, pg8::RowScale{nullptr, rsl, -1}, 256, 1 << 30, nullptr, 0};
          pg8::gemm_phase<pg8::EpiBf16, pg8::StaticOrder, PG8_ALIGN, PG8_SP2>(lds + RING_OFF, g, S, E); }
        { pg8::Gemm g{HB, WGU2, M, 2 * DFF, DM, DM, DM}; pg8::StaticOrder S; S.init(M, 2 * DFF, G, bid, WGM_ALL);
          PREP_RS(RS, SS2, S); pg8::EpiSwiGLU E{ACT, DFF, RS};
          pg8::gemm_phase<pg8::EpiSwiGLU, pg8::StaticOrder, PG8_ALIGN, PG8_SP2>(lds + RING_OFF, g, S, E); }
        if (tailfill && bid >= 128) {
          pg8::Gemm g{PBF, WPE, M, DM, PLE, PLE, PLE}; pg8::StaticOrder S; S.init(M, DM, 128, bid - 128, WGM_ALL); S.L0 = 512;
          pg8::EpiBf16 E{PE, DM, pg8::RowScale{nullptr, rsl, -1}, 256, 1 << 30, nullptr, 0};
          pg8::gemm_phase<pg8::EpiBf16, pg8::StaticOrder, PG8_ALIGN, PG8_SP2>(lds + RING_OFF, g, S, E); }
    }
    if (IN(8)) DRAIN_BG(T_D2);
    SEAM_BG(8);
    if (IN(9)) {
        pg8::Gemm g{ACT, WD2, M, DM, DFF, DFF, DFF}; g.krev = 1; pg8::StaticOrder S; S.init(M, DM, G, bid, WGM_DOWN);
        pg8::EpiResidBf E{HB, HB, DM, 0.5f, SS3};
        pg8::gemm_phase<pg8::EpiResidBf, pg8::StaticOrder, PG8_ALIGN, PG8_SP2>(lds + RING_OFF, g, S, E);
    }
    if (IN(9)) DRAIN_BG(NT_BG);
    SEAM(9);
    if (IN(10)) {
        pg8::Gemm g{HB, WPG, M, DM, DM, DM, DM}; pg8::StaticOrder S; S.init(M, DM, G, bid, WGM_ALL);
        PREP_RS(RS, SS3, S); pg8::EpiPleOut E{HB, PE, HF, DM, RS};
        pg8::gemm_phase<pg8::EpiPleOut, pg8::StaticOrder, PG8_ALIGN, PG8_SP2>(lds + RING_OFF, g, S, E);
    }
    SEAM(10);
    if (IN(11)) { for (int m = gw; m < M; m += NGW) rms_row_out(HF + (size_t)m * DM, out + (size_t)m * DM, g_fin, lane); }
#undef IN
#undef SEAM
#undef SEAM_BG
#undef DRAIN_BG
#undef TRY_BG
#undef BG_CONV
}

extern "C" void kernel_launch(void* const* d_in, const int* in_sizes, int n_in, void* d_out, int out_size, void* d_ws, size_t ws_size, hipStream_t stream) {
    static int grid = 0;
    if (grid == 0) {
        if (n_in != 19 || in_sizes[0] != M * DM || out_size != M * DM || ws_size < WS_END) { fprintf(stderr, "kernel_launch: shape mismatch (n_in %d, in0 %d, out %d, ws %zu, need %zu); nothing launched\n", n_in, n_in > 0 ? in_sizes[0] : -1, out_size, ws_size, (size_t)WS_END); grid = -1; return; }
        int dev = 0, cus = 0, per_cu = 0;
        if (hipGetDevice(&dev) != hipSuccess || hipDeviceGetAttribute(&cus, hipDeviceAttributeMultiprocessorCount, dev) != hipSuccess) { fprintf(stderr, "kernel_launch: device query failed\n"); grid = -1; return; }
        if (hipFuncSetAttribute((const void*)mega_fwd, hipFuncAttributeMaxDynamicSharedMemorySize, LDS_BYTES) != hipSuccess) { fprintf(stderr, "kernel_launch: hipFuncSetAttribute failed\n"); grid = -1; return; }
        if (hipOccupancyMaxActiveBlocksPerMultiprocessor(&per_cu, (const void*)mega_fwd, NWAVES * 64, LDS_BYTES) != hipSuccess || per_cu < 1) fprintf(stderr, "kernel_launch: note: occupancy query reports %d blocks per CU\n", per_cu);
        (void)hipGetLastError();
        grid = cus;
        fprintf(stderr, "kernel_launch: grid %d, ws %zu (need %zu)\n", grid, ws_size, (size_t)WS_END);
    }
    if (grid < 0) return;
    if (hipMemsetAsync((char*)d_ws + WS_CTL, 0, CTL_ZERO_BYTES, stream) != hipSuccess) { fprintf(stderr, "kernel_launch: memset failed\n"); return; }
    Args a{};
    for (int i = 0; i < 19; ++i) a.in[i] = (const float*)d_in[i];
    a.out = (float*)d_out; a.ws = (unsigned char*)d_ws;
    for (int li = 0; li < MK_N_LAUNCHES; ++li) {
        a.ph_lo = (MK_N_LAUNCHES == 1) ? 0 : li; a.ph_hi = (MK_N_LAUNCHES == 1) ? N_PHASES : li + 1;
        hipLaunchKernelGGL(mega_fwd, dim3(grid), dim3(NWAVES * 64), LDS_BYTES, stream, a);
        const hipError_t le = hipPeekAtLastError();
        if (le != hipSuccess) { fprintf(stderr, "kernel_launch: launch %d failed: %s\n", li, hipGetErrorName(le)); break; }
    }
}
```

```cpp
#include <hip/hip_runtime.h>
#include <cstdio>
#include <cstdint>
#include <cmath>
namespace pg8 {
#define PG8_LAS __attribute__((address_space(3)))
typedef unsigned short bf16_t;
typedef short bf16x8 __attribute__((ext_vector_type(8)));
typedef float f32x4 __attribute__((ext_vector_type(4)));
typedef unsigned u32x4 __attribute__((ext_vector_type(4)));
constexpr int BM = 256, BK = 64, HALF = 128, HTB = HALF * BK * 2  , STAGE_BYTES = 8 * HTB, NXCD = 8;

__host__ __device__ __forceinline__ int lds_byte(int r, int c) { const int st = (r >> 4) * 2 + (c >> 5), rr = r & 15, cc = c & 31, ob = rr * 64 + cc * 2; return st * 1024 + (ob ^ (((ob >> 9) & 1) << 5)); }
__host__ __device__ __forceinline__ void stage_rc(int b, int& R, int& C) { const int st = b / 1024, sb = b % 1024, swz = sb ^ (((sb >> 9) & 1) << 5); R = (st >> 1) * 16 + swz / 64; C = (st & 1) * 32 + (swz % 64) / 2; }
__host__ __device__ __forceinline__ int perm32(int rho) { const int n = rho >> 4, i = rho & 15; return 8 * (i >> 2) + 4 * n + (i & 3); }

struct Unit { int pm, pn; };
struct Gemm { const bf16_t* A; const bf16_t* Bt; int M, N, K, lda, ldb; int pmulA = 1, pmulB = 1; int krev = 0; };

struct StaticOrder {
    int nM, nN, nwg, G, c, WGM, L0, Lend;
    __host__ __device__ __forceinline__ void init(int M, int N, int G_, int c_, int wgm = 8) { nM = M / BM; nN = N / BM; nwg = nM * nN; G = G_; c = c_; WGM = wgm; L0 = 0; Lend = nwg; }
    __host__ __device__ __forceinline__ bool next(int i, Unit& u) const {
        const long L = (long)L0 + (long)i * G + c; if (L >= Lend) return false;
        int wgid = (int)L; { const int q = nwg / NXCD, r = nwg % NXCD, xcd = wgid % NXCD, off = wgid / NXCD; wgid = (xcd < r ? xcd * (q + 1) : r * (q + 1) + (xcd - r) * q) + off; }
        const int nig = WGM * nN, gid = wgid / nig, fm = gid * WGM, gsz = (nM - fm) < WGM ? (nM - fm) : WGM;
        u.pm = fm + ((wgid % nig) % gsz); u.pn = (wgid % nig) / gsz; return true;
    }
    __device__ __forceinline__ void a_ready(const Unit&) const {}
    __device__ __forceinline__ void done(const Unit&) const {}
};

__device__ __forceinline__ unsigned cvt_pk_bf16(float lo, float hi) { unsigned r; asm volatile("v_cvt_pk_bf16_f32 %0, %1, %2" : "=v"(r) : "v"(lo), "v"(hi)); return r; }
typedef unsigned u32x2 __attribute__((ext_vector_type(2)));
__device__ __forceinline__ float sigm(float x) { return __builtin_amdgcn_rcpf(1.0f + __builtin_amdgcn_exp2f(-1.4426950408889634f * x)); }
__device__ __forceinline__ float bf_lo(unsigned w) { return __uint_as_float(w << 16); }
__device__ __forceinline__ float bf_hi(unsigned w) { return __uint_as_float(w & 0xffff0000u); }

struct RowScale { const float* SS; const PG8_LAS float* rsl; int pm0; };
__device__ __forceinline__ void load_rstd(float (&rs)[2][4], const RowScale& R, int pm, int r0) {
    if (!R.SS) {
#pragma unroll
        for (int ai = 0; ai < 2; ++ai)
#pragma unroll
            for (int m = 0; m < 4; ++m) rs[ai][m] = 1.0f;
        return; }
    if (pm == R.pm0) {
#pragma unroll
        for (int ai = 0; ai < 2; ++ai)
#pragma unroll
            for (int m = 0; m < 4; ++m) rs[ai][m] = R.rsl[r0 + ai * HALF + m * 16];
        return; }
#pragma unroll
    for (int ai = 0; ai < 2; ++ai)
#pragma unroll
        for (int m = 0; m < 4; ++m) rs[ai][m] = __builtin_amdgcn_rsqf(R.SS[pm * BM + r0 + ai * HALF + m * 16] * (1.0f / 4096.0f) + 1e-6f);
}
struct EpiBf16 {
    static constexpr bool PERM = true, AFTER_DRAIN = false;
    bf16_t* O; int ldc; RowScale RS; size_t ts; int split; bf16_t* O2; int ldc2;
    __device__ __forceinline__ void operator()(const f32x4 (&acc)[2][2][4][2], const Unit& u, int wr, int wc, int fr, int fq) const {
        const bool first = u.pn < split;
        const int row0 = u.pm * BM + wr * 64 + fr, cw = wc * 32 + 8 * fq, ld = first ? ldc : ldc2;
        bf16_t* tb = first ? O + (size_t)u.pn * ts : O2 + (size_t)(u.pn - split) * BM;
        float rsv[2][4]; load_rstd(rsv, RS, u.pm, wr * 64 + fr);
#pragma unroll
        for (int ai = 0; ai < 2; ++ai)
#pragma unroll
            for (int m = 0; m < 4; ++m) { const int row = row0 + ai * HALF + m * 16; bf16_t* rowp = tb + (size_t)row * ld + cw; const float r = rsv[ai][m];
#pragma unroll
                for (int bj = 0; bj < 2; ++bj) { const f32x4 v0 = acc[ai][bj][m][0] * r, v1 = acc[ai][bj][m][1] * r;
                    u32x4 w; w.x = cvt_pk_bf16(v0[0], v0[1]); w.y = cvt_pk_bf16(v0[2], v0[3]); w.z = cvt_pk_bf16(v1[0], v1[1]); w.w = cvt_pk_bf16(v1[2], v1[3]);
                    *(u32x4*)(rowp + bj * HALF) = w; } }
    }
};
struct EpiSwiGLU {
    static constexpr bool PERM = true, AFTER_DRAIN = false;
    bf16_t* O; int ldc; RowScale RS;
    __device__ __forceinline__ void operator()(const f32x4 (&acc)[2][2][4][2], const Unit& u, int wr, int wc, int fr, int fq) const {
        const int row0 = u.pm * BM + wr * 64 + fr, col0 = u.pn * HALF + wc * 32 + 8 * fq;
        float rsv[2][4]; load_rstd(rsv, RS, u.pm, wr * 64 + fr);
#pragma unroll
        for (int ai = 0; ai < 2; ++ai)
#pragma unroll
            for (int m = 0; m < 4; ++m) { const int row = row0 + ai * HALF + m * 16; bf16_t* rowp = O + (size_t)row * ldc + col0; const float rs = rsv[ai][m];
                const float ka = -1.4426950408889634f * rs, kb = rs * rs;
                const f32x4 g0 = acc[ai][0][m][0], g1 = acc[ai][0][m][1], u0 = acc[ai][1][m][0], u1 = acc[ai][1][m][1];
                f32x4 e0 = g0 * ka, e1 = g1 * ka;
#pragma unroll
                for (int j = 0; j < 4; ++j) { e0[j] = __builtin_amdgcn_exp2f(e0[j]); e1[j] = __builtin_amdgcn_exp2f(e1[j]); }
                e0 = e0 + 1.0f; e1 = e1 + 1.0f;
#pragma unroll
                for (int j = 0; j < 4; ++j) { e0[j] = __builtin_amdgcn_rcpf(e0[j]); e1[j] = __builtin_amdgcn_rcpf(e1[j]); }
                const f32x4 t0 = ((g0 * u0) * kb) * e0, t1 = ((g1 * u1) * kb) * e1;
                u32x4 w; w.x = cvt_pk_bf16(t0[0], t0[1]); w.y = cvt_pk_bf16(t0[2], t0[3]); w.z = cvt_pk_bf16(t1[0], t1[1]); w.w = cvt_pk_bf16(t1[2], t1[3]);
                *(u32x4*)rowp = w; }
    }
};
struct EpiResidBf {
    static constexpr bool PERM = true, AFTER_DRAIN = false;
    const bf16_t* Hin; bf16_t* Hout; int ldc; float alpha; float* SS;
    __device__ __forceinline__ void operator()(const f32x4 (&acc)[2][2][4][2], const Unit& u, int wr, int wc, int fr, int fq) const {
        const int row0 = u.pm * BM + wr * 64 + fr, col0 = u.pn * BM + wc * 32 + 8 * fq;
        u32x4 hw[2][4][2];
#pragma unroll
        for (int ai = 0; ai < 2; ++ai)
#pragma unroll
            for (int m = 0; m < 4; ++m)
#pragma unroll
                for (int bj = 0; bj < 2; ++bj) hw[ai][m][bj] = *(const u32x4*)(Hin + (size_t)(row0 + ai * HALF + m * 16) * ldc + col0 + bj * HALF);
#pragma unroll
        for (int ai = 0; ai < 2; ++ai)
#pragma unroll
            for (int m = 0; m < 4; ++m) { const int row = row0 + ai * HALF + m * 16; float ssq = 0.f;
#pragma unroll
                for (int bj = 0; bj < 2; ++bj) { const size_t p = (size_t)row * ldc + col0 + bj * HALF; float r[8]; const u32x4 h4 = hw[ai][m][bj];
                    r[0] = bf_lo(h4.x); r[1] = bf_hi(h4.x); r[2] = bf_lo(h4.y); r[3] = bf_hi(h4.y); r[4] = bf_lo(h4.z); r[5] = bf_hi(h4.z); r[6] = bf_lo(h4.w); r[7] = bf_hi(h4.w);
                    const f32x4 v0 = acc[ai][bj][m][0], v1 = acc[ai][bj][m][1];
#pragma unroll
                    for (int j = 0; j < 4; ++j) { r[j] += alpha * v0[j]; r[4 + j] += alpha * v1[j]; }
#pragma unroll
                    for (int j = 0; j < 8; ++j) ssq += r[j] * r[j];
                    u32x4 w; w.x = cvt_pk_bf16(r[0], r[1]); w.y = cvt_pk_bf16(r[2], r[3]); w.z = cvt_pk_bf16(r[4], r[5]); w.w = cvt_pk_bf16(r[6], r[7]);
                    *(u32x4*)(Hout + p) = w; }
                ssq += __shfl_xor(ssq, 16); ssq += __shfl_xor(ssq, 32);
                if (fq == 0) (void)__hip_atomic_fetch_add(SS + row, ssq, __ATOMIC_RELAXED, __HIP_MEMORY_SCOPE_AGENT); }
    }
};
struct EpiPleOut {
    static constexpr bool PERM = true, AFTER_DRAIN = false;
    const bf16_t* H; const bf16_t* PE; bf16_t* O; int ldc; RowScale RS;
    __device__ __forceinline__ void operator()(const f32x4 (&acc)[2][2][4][2], const Unit& u, int wr, int wc, int fr, int fq) const {
        const int row0 = u.pm * BM + wr * 64 + fr, col0 = u.pn * BM + wc * 32 + 8 * fq;
        float rsv[2][4]; load_rstd(rsv, RS, u.pm, wr * 64 + fr);
#pragma unroll
        for (int ai = 0; ai < 2; ++ai) {
            u32x4 hq[4][2], pq[4][2];
#pragma unroll
            for (int m = 0; m < 4; ++m)
#pragma unroll
                for (int bj = 0; bj < 2; ++bj) { const size_t p = (size_t)(row0 + ai * HALF + m * 16) * ldc + col0 + bj * HALF; hq[m][bj] = *(const u32x4*)(H + p); pq[m][bj] = *(const u32x4*)(PE + p); }
#pragma unroll
            for (int m = 0; m < 4; ++m) { const int row = row0 + ai * HALF + m * 16; const float rs = rsv[ai][m];
#pragma unroll
                for (int bj = 0; bj < 2; ++bj) { const size_t p = (size_t)row * ldc + col0 + bj * HALF; const u32x4 hw = hq[m][bj], pw = pq[m][bj];
                    const float ka = -1.4426950408889634f * rs;
                    f32x4 e0 = acc[ai][bj][m][0] * ka, e1 = acc[ai][bj][m][1] * ka;
#pragma unroll
                    for (int j = 0; j < 4; ++j) { e0[j] = __builtin_amdgcn_exp2f(e0[j]); e1[j] = __builtin_amdgcn_exp2f(e1[j]); }
                    e0 = e0 + 1.0f; e1 = e1 + 1.0f;
#pragma unroll
                    for (int j = 0; j < 4; ++j) { e0[j] = __builtin_amdgcn_rcpf(e0[j]); e1[j] = __builtin_amdgcn_rcpf(e1[j]); }
                    const f32x4 h0 = {bf_lo(hw.x), bf_hi(hw.x), bf_lo(hw.y), bf_hi(hw.y)}, h1 = {bf_lo(hw.z), bf_hi(hw.z), bf_lo(hw.w), bf_hi(hw.w)};
                    const f32x4 q0 = {bf_lo(pw.x), bf_hi(pw.x), bf_lo(pw.y), bf_hi(pw.y)}, q1 = {bf_lo(pw.z), bf_hi(pw.z), bf_lo(pw.w), bf_hi(pw.w)};
                    const f32x4 o0 = h0 + e0 * q0, o1 = h1 + e1 * q1;
                    u32x4 w; w.x = cvt_pk_bf16(o0[0], o0[1]); w.y = cvt_pk_bf16(o0[2], o0[3]); w.z = cvt_pk_bf16(o1[0], o1[1]); w.w = cvt_pk_bf16(o1[2], o1[3]);
                    *(u32x4*)(O + p) = w; } } }
    }
};
template <bool ACCUM> struct EpiGate {
    static constexpr bool PERM = true, AFTER_DRAIN = false;
    const bf16_t* G; int ldg; bf16_t* Z; int ldz;
    __device__ __forceinline__ void operator()(const f32x4 (&acc)[2][2][4][2], const Unit& u, int wr, int wc, int fr, int fq) const {
        const int row0 = u.pm * BM + wr * 64 + fr, col0 = u.pn * BM + wc * 32 + 8 * fq;
#pragma unroll
        for (int ai = 0; ai < 2; ++ai) {
            u32x4 gq[4][2], zq[4][2];
#pragma unroll
            for (int m = 0; m < 4; ++m)
#pragma unroll
                for (int bj = 0; bj < 2; ++bj) { const size_t row = (size_t)(row0 + ai * HALF + m * 16); gq[m][bj] = *(const u32x4*)(G + row * ldg + col0 + bj * HALF);
                    if (ACCUM) zq[m][bj] = *(const u32x4*)(Z + row * ldz + col0 + bj * HALF); }
#pragma unroll
            for (int m = 0; m < 4; ++m) { const size_t row = (size_t)(row0 + ai * HALF + m * 16);
#pragma unroll
                for (int bj = 0; bj < 2; ++bj) { const u32x4 gw = gq[m][bj]; bf16_t* zp = Z + row * ldz + col0 + bj * HALF;
                    const f32x4 v0 = acc[ai][bj][m][0], v1 = acc[ai][bj][m][1];
                    f32x4 e0 = {bf_lo(gw.x), bf_hi(gw.x), bf_lo(gw.y), bf_hi(gw.y)}, e1 = {bf_lo(gw.z), bf_hi(gw.z), bf_lo(gw.w), bf_hi(gw.w)};
                    e0 = e0 * -1.4426950408889634f; e1 = e1 * -1.4426950408889634f;
#pragma unroll
                    for (int j = 0; j < 4; ++j) { e0[j] = __builtin_amdgcn_exp2f(e0[j]); e1[j] = __builtin_amdgcn_exp2f(e1[j]); }
                    e0 = e0 + 1.0f; e1 = e1 + 1.0f;
#pragma unroll
                    for (int j = 0; j < 4; ++j) { e0[j] = __builtin_amdgcn_rcpf(e0[j]); e1[j] = __builtin_amdgcn_rcpf(e1[j]); }
                    f32x4 r0 = e0 * v0, r1 = e1 * v1;
                    if (ACCUM) { const u32x4 zw = zq[m][bj];
                        r0 = r0 + (f32x4){bf_lo(zw.x), bf_hi(zw.x), bf_lo(zw.y), bf_hi(zw.y)}; r1 = r1 + (f32x4){bf_lo(zw.z), bf_hi(zw.z), bf_lo(zw.w), bf_hi(zw.w)}; }
                    u32x4 w; w.x = cvt_pk_bf16(r0[0], r0[1]); w.y = cvt_pk_bf16(r0[2], r0[3]); w.z = cvt_pk_bf16(r1[0], r1[1]); w.w = cvt_pk_bf16(r1[2], r1[3]);
                    *(u32x4*)zp = w; } } }
    }
};

template <class Epi, class Sched, bool ALIGN_EPI = false, bool SP2 = false>
__device__ __forceinline__ void gemm_phase(PG8_LAS unsigned char* lds, const Gemm g, const Sched& S, const Epi& E) {
    const int tid = threadIdx.x, wid = __builtin_amdgcn_readfirstlane(tid >> 6), lane = tid & 63, wr = wid >> 2, wc = wid & 3, fr = lane & 15, fq = lane >> 4;
    const int K = g.K, nt = K / BK;
    unsigned voffA[2], voffB[2];
#pragma unroll
    for (int i = 0; i < 2; ++i) { int R, C; stage_rc(tid * 16 + i * 8192, R, C); const int Rb = Epi::PERM ? ((R & ~31) + perm32(R & 31)) : R;
        voffA[i] = (unsigned)(R * g.lda + C) * 2u; voffB[i] = (unsigned)(Rb * g.ldb + C) * 2u; }
    const long kstep = g.krev ? -(long)(BK * 2) : (long)(BK * 2);
    const size_t kfirst = g.krev ? (size_t)(K / BK - 1) * (BK * 2) : 0;
    const size_t hstepA = (size_t)HALF * g.lda * 2, hstepB = (size_t)HALF * g.ldb * 2;
    const size_t tstepA = 2 * hstepA, tstepB = 2 * hstepB;
    const unsigned ldsw = (unsigned)wid * 1024u;
    const int aoff = lds_byte(wr * 64 + fr, fq * 8), boff = lds_byte(wc * 32 + fr, fq * 8);
#define PG8_SA(b, h) (((b) * 2 + (h)) * HTB)
#define PG8_SB(b, h) ((4 + (b) * 2 + (h)) * HTB)
#define PG8_STAGE(bufoff, gbase, voff) do { _Pragma("unroll") for (int _i = 0; _i < 2; ++_i) \
        __builtin_amdgcn_global_load_lds((const unsigned*)((const char*)(gbase) + (voff)[_i]), (PG8_LAS unsigned*)(lds + (bufoff) + ldsw + _i * 8192), 16, 0, 0); } while (0)
#define PG8_LDA(dst, b, h) do { _Pragma("unroll") for (int m = 0; m < 4; ++m) _Pragma("unroll") for (int k = 0; k < 2; ++k) dst[m][k] = *(const PG8_LAS bf16x8*)(lds + PG8_SA(b, h) + aoff + m * 2048 + k * 1024); } while (0)
#define PG8_LDB(dst, b, h) do { _Pragma("unroll") for (int n = 0; n < 2; ++n) _Pragma("unroll") for (int k = 0; k < 2; ++k) dst[n][k] = *(const PG8_LAS bf16x8*)(lds + PG8_SB(b, h) + boff + n * 2048 + k * 1024); } while (0)
#define PG8_MMA(ai, bj, At, Bt) do { __builtin_amdgcn_s_setprio(1); _Pragma("unroll") for (int m = 0; m < 4; ++m) _Pragma("unroll") for (int n = 0; n < 2; ++n) _Pragma("unroll") for (int k = 0; k < 2; ++k) \
        acc[ai][bj][m][n] = __builtin_amdgcn_mfma_f32_16x16x32_bf16(Bt[n][k], At[m][k], acc[ai][bj][m][n], 0, 0, 0); __builtin_amdgcn_s_setprio(0); } while (0)
#define PG8_WAIT_V(n) asm volatile("s_waitcnt vmcnt(" #n ")" ::: "memory")
#define PG8_WAIT_L(n) asm volatile("s_waitcnt lgkmcnt(" #n ")" ::: "memory")
#define PG8_BAR __builtin_amdgcn_s_barrier()
#define PG8_SCHED __builtin_amdgcn_sched_barrier(0)
    Unit cur, nxt; int ui = 0;
    if (!S.next(0, cur)) return;
    f32x4 acc[2][2][4][2];
#pragma unroll
    for (int a = 0; a < 2; ++a)
#pragma unroll
        for (int b = 0; b < 2; ++b)
#pragma unroll
            for (int m = 0; m < 4; ++m)
#pragma unroll
                for (int n = 0; n < 2; ++n) acc[a][b][m][n] = (f32x4){0.f, 0.f, 0.f, 0.f};
    bf16x8 At[4][2], B0[2][2], B1[2][2];
    const char* cA = (const char*)g.A + (size_t)(cur.pm * g.pmulA) * tstepA + kfirst; const char* cB = (const char*)g.Bt + (size_t)(cur.pn * g.pmulB) * tstepB + kfirst;
    S.a_ready(cur);
    if constexpr (SP2) {
        PG8_STAGE(PG8_SB(0, 0), cB, voffB); PG8_STAGE(PG8_SB(0, 1), cB + hstepB, voffB); PG8_STAGE(PG8_SA(0, 0), cA, voffA); PG8_STAGE(PG8_SA(0, 1), cA + hstepA, voffA);
        if (wr == 1) PG8_BAR;
        PG8_WAIT_V(2); PG8_BAR;
        PG8_STAGE(PG8_SB(1, 0), cB + kstep, voffB); PG8_STAGE(PG8_SA(1, 0), cA + kstep, voffA); PG8_STAGE(PG8_SB(1, 1), cB + hstepB + kstep, voffB);
        PG8_WAIT_V(6); PG8_BAR;
    } else {
        PG8_STAGE(PG8_SB(0, 0), cB, voffB); PG8_STAGE(PG8_SA(0, 0), cA, voffA); PG8_STAGE(PG8_SB(0, 1), cB + hstepB, voffB); PG8_STAGE(PG8_SA(0, 1), cA + hstepA, voffA);
        if (wr == 1) PG8_BAR;
        PG8_WAIT_V(4); PG8_BAR;
        PG8_STAGE(PG8_SB(1, 0), cB + kstep, voffB); PG8_STAGE(PG8_SA(1, 0), cA + kstep, voffA); PG8_STAGE(PG8_SB(1, 1), cB + hstepB + kstep, voffB);
        PG8_WAIT_V(6); PG8_BAR;
    }
    for (;;) {
        const bool has_next = S.next(ui + 1, nxt);
        const char* nA = has_next ? (const char*)g.A + (size_t)(nxt.pm * g.pmulA) * tstepA + kfirst : cA; const char* nB = has_next ? (const char*)g.Bt + (size_t)(nxt.pn * g.pmulB) * tstepB + kfirst : cB;
        for (int t = 0; t < nt; t += 2) {
            const bool last = (t == nt - 2);
            const char* a1 = cA + (long)(t + 1) * kstep;
            const char* a2 = last ? nA : cA + (long)(t + 2) * kstep; const char* b2 = last ? nB : cB + (long)(t + 2) * kstep;
            const char* a3 = a2 + kstep; const char* b3 = b2 + kstep;
            if (last && has_next) S.a_ready(nxt);
            if constexpr (SP2) {
            PG8_LDB(B0, 0, 0); PG8_LDB(B1, 0, 1); PG8_SCHED; PG8_LDA(At, 0, 0); PG8_STAGE(PG8_SA(1, 1), a1 + hstepA, voffA);
            PG8_WAIT_V(8); PG8_WAIT_L(0); PG8_BAR; PG8_MMA(0, 0, At, B0); PG8_MMA(0, 1, At, B1); PG8_BAR; PG8_SCHED;
            PG8_LDA(At, 0, 1); PG8_STAGE(PG8_SB(0, 0), b2, voffB); PG8_STAGE(PG8_SB(0, 1), b2 + hstepB, voffB); PG8_STAGE(PG8_SA(0, 0), a2, voffA);
            PG8_WAIT_V(8); PG8_WAIT_L(0); PG8_BAR; PG8_MMA(1, 0, At, B0); PG8_MMA(1, 1, At, B1); PG8_BAR; PG8_SCHED;
            PG8_LDB(B0, 1, 0); PG8_LDB(B1, 1, 1); PG8_SCHED; PG8_LDA(At, 1, 0); PG8_STAGE(PG8_SA(0, 1), a2 + hstepA, voffA);
            PG8_WAIT_V(8); PG8_WAIT_L(0); PG8_BAR; PG8_MMA(0, 0, At, B0); PG8_MMA(0, 1, At, B1); PG8_BAR; PG8_SCHED;
            PG8_LDA(At, 1, 1); PG8_STAGE(PG8_SB(1, 0), b3, voffB); PG8_STAGE(PG8_SB(1, 1), b3 + hstepB, voffB); PG8_STAGE(PG8_SA(1, 0), a3, voffA);
            PG8_WAIT_V(8); PG8_WAIT_L(0); PG8_BAR; PG8_MMA(1, 0, At, B0); PG8_MMA(1, 1, At, B1); PG8_BAR; PG8_SCHED;
            } else {
            PG8_LDB(B0, 0, 0); PG8_SCHED; PG8_LDA(At, 0, 0); PG8_STAGE(PG8_SA(1, 1), a1 + hstepA, voffA);
            PG8_WAIT_L(8); PG8_BAR; PG8_WAIT_L(0); PG8_MMA(0, 0, At, B0); PG8_BAR; PG8_SCHED;
            PG8_LDB(B1, 0, 1); PG8_STAGE(PG8_SB(0, 0), b2, voffB);
            PG8_BAR; PG8_WAIT_L(0); PG8_MMA(0, 1, At, B1); PG8_BAR;
            PG8_LDA(At, 0, 1); PG8_STAGE(PG8_SA(0, 0), a2, voffA);
            PG8_BAR; PG8_WAIT_L(0); PG8_MMA(1, 0, At, B0); PG8_BAR; PG8_SCHED;
            PG8_STAGE(PG8_SB(0, 1), b2 + hstepB, voffB);
            PG8_WAIT_V(6); PG8_BAR; PG8_MMA(1, 1, At, B1); PG8_BAR;
            PG8_LDB(B0, 1, 0); PG8_SCHED; PG8_LDA(At, 1, 0); PG8_STAGE(PG8_SA(0, 1), a2 + hstepA, voffA);
            PG8_WAIT_L(8); PG8_BAR; PG8_WAIT_L(0); PG8_MMA(0, 0, At, B0); PG8_BAR; PG8_SCHED;
            PG8_LDB(B1, 1, 1); PG8_STAGE(PG8_SB(1, 0), b3, voffB);
            PG8_BAR; PG8_WAIT_L(0); PG8_MMA(0, 1, At, B1); PG8_BAR;
            PG8_LDA(At, 1, 1); PG8_STAGE(PG8_SA(1, 0), a3, voffA);
            PG8_BAR; PG8_WAIT_L(0); PG8_MMA(1, 0, At, B0); PG8_BAR; PG8_SCHED;
            PG8_STAGE(PG8_SB(1, 1), b3 + hstepB, voffB);
            PG8_WAIT_V(6); PG8_BAR; PG8_MMA(1, 1, At, B1); PG8_BAR;
            }
        }
        if constexpr (ALIGN_EPI) { if (wr == 0) PG8_BAR; }
        if constexpr (!Epi::AFTER_DRAIN) { E(acc, cur, wr, wc, fr, fq); S.done(cur); }
        if (!has_next) break;
#pragma unroll
        for (int a = 0; a < 2; ++a)
#pragma unroll
            for (int b = 0; b < 2; ++b)
#pragma unroll
                for (int m = 0; m < 4; ++m)
#pragma unroll
                    for (int n = 0; n < 2; ++n) acc[a][b][m][n] = (f32x4){0.f, 0.f, 0.f, 0.f};
        cur = nxt; cA = nA; cB = nB; ++ui;
        if constexpr (ALIGN_EPI) { if (wr == 1) PG8_BAR; }
    }
    PG8_WAIT_V(0);
    if constexpr (!ALIGN_EPI) { if (wr == 0) PG8_BAR; }
    PG8_BAR;
    if constexpr (Epi::AFTER_DRAIN) { E.fused(acc, cur, wr, wc, fr, fq, lds, wid, lane); S.done(cur); }
#undef PG8_SA
#undef PG8_SB
#undef PG8_STAGE
#undef PG8_LDA
#undef PG8_LDB
#undef PG8_MMA
#undef PG8_WAIT_V
#undef PG8_WAIT_L
#undef PG8_BAR
#undef PG8_SCHED
}
}

#ifndef WGM_ALL
#define WGM_ALL 8
#endif
#ifndef WGM_DOWN
#define WGM_DOWN 2
#endif
#ifndef PG8_SP2
#define PG8_SP2 true
#endif
#ifndef PG8_ALIGN
#define PG8_ALIGN true
#endif
constexpr int NWAVES = 8;
constexpr int BATCH = 4, SEQ = 4096, DM = 4096, M = BATCH * SEQ;
constexpr int DFF = 11008, PLE = 256, HD = 128, NH = 16, AW = NH * HD;
constexpr int INC = 6 * AW + 2 * DM;
constexpr int C_QA = 0, C_KA = AW, C_VA = 2 * AW, C_QB = 3 * AW, C_KB = 4 * AW, C_VB = 5 * AW, C_GA = 6 * AW, C_GB = 6 * AW + DM;
constexpr int MB = 256, NBLK = SEQ / MB;
constexpr float RMS_EPS = 1e-6f;
#ifndef MK_N_LAUNCHES
#define MK_N_LAUNCHES 1
#endif
constexpr int N_PHASES = 12;
static_assert(MK_N_LAUNCHES == 1 || MK_N_LAUNCHES == N_PHASES, "MK_N_LAUNCHES is 1 (one launch) or 12 (one launch per phase: debugging)");

constexpr size_t MiB = 1u << 20;
constexpr size_t WS_CTL = 0, CTL_ZERO_BYTES = 512 * 1024;
constexpr size_t WS_KM   = 1 * MiB;
constexpr size_t WS_WGU1 = 2 * MiB;
constexpr size_t WS_WD1  = WS_WGU1 + (size_t)2 * DFF * DM * 2;
constexpr size_t WS_WIN  = WS_WD1 + (size_t)DM * DFF * 2;
constexpr size_t WS_WBR  = WS_WIN + (size_t)INC * DM * 2;
constexpr size_t WS_WOUT = WS_WBR + (size_t)DM * 2 * AW * 2;
constexpr size_t WS_WGU2 = WS_WOUT + (size_t)DM * DM * 2;
constexpr size_t WS_WD2  = WS_WGU2 + (size_t)2 * DFF * DM * 2;
constexpr size_t WS_WPG  = WS_WD2 + (size_t)DM * DFF * 2;
constexpr size_t WS_WPE  = WS_WPG + (size_t)DM * DM * 2;
constexpr size_t WS_PBF  = WS_WPE + (size_t)DM * PLE * 2;
constexpr size_t WS_XBZ  = WS_PBF + (size_t)M * PLE * 2;
constexpr size_t WS_HB   = WS_XBZ + (size_t)M * DM * 2;
constexpr size_t WS_ATT  = WS_HB + (size_t)M * DM * 2;
constexpr size_t WS_R1   = WS_ATT + (size_t)M * DM * 2;
constexpr size_t WS_END  = WS_R1 + (size_t)M * INC * 2;
static_assert(WS_END <= (size_t)1908490240, "d_ws map must fit the guaranteed workspace (sum of the inputs)");
static_assert((WS_WD1 % 256) == 0 && (WS_WIN % 256) == 0 && (WS_XBZ % 256) == 0 && (WS_R1 % 256) == 0, "alignment");
constexpr size_t WS_SS0 = 448 * 1024, WS_SS1 = 256 * 1024, WS_SS2 = 320 * 1024, WS_SS3 = 384 * 1024;
constexpr int CW_TMO = 0, CW_CODE = 1;
constexpr int CW_BG = 12288;
constexpr int CW_QUEUE = 8192;
constexpr int CW_BAR = 4096;

constexpr int RING_OFF = 0, RING_BYTES = 135168;
constexpr int LDSCTL_OFF = RING_BYTES, MISC_OFF = LDSCTL_OFF + 320;
constexpr int LDS_BYTES = 147456;
static_assert(MISC_OFF + 128 <= LDS_BYTES, "LDS map");

#define GAS __attribute__((address_space(1)))
#define LAS __attribute__((address_space(3)))
typedef unsigned short bf16;
typedef unsigned v4u __attribute__((ext_vector_type(4)));
typedef unsigned v2u __attribute__((ext_vector_type(2)));
typedef float f32x4 __attribute__((ext_vector_type(4)));
typedef float f32x16 __attribute__((ext_vector_type(16)));
typedef short bf16x8 __attribute__((ext_vector_type(8)));
typedef short s16x4 __attribute__((ext_vector_type(4)));
typedef GAS unsigned gu32;
#define RLX_AGENT __ATOMIC_RELAXED, __HIP_MEMORY_SCOPE_AGENT
#define LDS_WAIT() asm volatile("s_waitcnt lgkmcnt(0)" ::: "memory")
#define VM_WAIT() asm volatile("s_waitcnt vmcnt(0)" ::: "memory")
#define SBAR() __builtin_amdgcn_sched_barrier(0)
__device__ __forceinline__ unsigned cvtpk(float lo, float hi) { unsigned r; asm volatile("v_cvt_pk_bf16_f32 %0, %1, %2" : "=v"(r) : "v"(lo), "v"(hi)); return r; }
typedef __bf16 bf16x2_t __attribute__((ext_vector_type(2)));
typedef float f32x2_t __attribute__((ext_vector_type(2)));
__device__ __forceinline__ unsigned cvtpk_c(float lo, float hi) { f32x2_t v = {lo, hi}; bf16x2_t b = __builtin_convertvector(v, bf16x2_t); return __builtin_bit_cast(unsigned, b); }

#define XB_TMO      128
#define XB_XCNT(j)  (256  + 64 * (j))
#define XB_XSUB(j)  (1280 + 64 * (j))
#define XB_XGEN(j)  (2304 + 64 * (j))
#define XB_TOP      3328
#define XB_TOPGEN   3392
#define XCD_BAR_WORDS 3456
#define XB_SPIN_CAP (1u << 18)

__device__ __forceinline__ unsigned xb_ld(unsigned* p)              { return __hip_atomic_load(p, __ATOMIC_RELAXED, __HIP_MEMORY_SCOPE_AGENT); }
__device__ __forceinline__ unsigned xb_add(unsigned* p, unsigned v) { return __hip_atomic_fetch_add(p, v, __ATOMIC_RELAXED, __HIP_MEMORY_SCOPE_AGENT); }
__device__ __forceinline__ unsigned xb_xcc_id() { return (unsigned)__builtin_amdgcn_s_getreg((3 << 11) | 20) & 0xFu; }
#define XB_SPIN(cond, bar) do { unsigned _sp = 0; while (cond) { __builtin_amdgcn_s_sleep(1); \
    if ((++_sp & 255u) == 0u) { if (xb_ld(&(bar)[XB_TMO])) break; if (_sp > XB_SPIN_CAP) { atomicAdd(&(bar)[XB_TMO], 1u); break; } } } } while (0)

struct XcdBarrier {
    unsigned* bar; unsigned x;
    volatile LAS unsigned* st;
};

__device__ __forceinline__ XcdBarrier xcd_barrier_post(unsigned* bar, volatile LAS unsigned* st) {
    XcdBarrier b; b.bar = bar; b.x = xb_xcc_id(); b.st = st;
    if (threadIdx.x == 0) (void)xb_add(&bar[XB_XCNT(b.x)], 1u);
    return b;
}
__device__ __forceinline__ void xcd_barrier_complete(unsigned* bar, unsigned x, unsigned& nloc, unsigned& nx) {
    const unsigned G = gridDim.x * gridDim.y * gridDim.z;
    unsigned sum, cnt, mine, sp = 0u;
    for (;;) {
        sum = 0u; cnt = 0u; mine = 0u;
#pragma unroll
        for (unsigned j = 0; j < 16; ++j) { const unsigned c = xb_ld(&bar[XB_XCNT(j)]); sum += c; cnt += (c > 0u) ? 1u : 0u; mine = (j == x) ? c : mine; }
        if (sum == G) break;
        __builtin_amdgcn_s_sleep(1);
        if ((++sp & 255u) == 0u) { if (xb_ld(&bar[XB_TMO])) break; if (sp > XB_SPIN_CAP) { atomicAdd(&bar[XB_TMO], 1u); break; } }
    }
    nloc = mine > 0u ? mine : 1u; nx = cnt > 0u ? cnt : 1u;
}

__device__ __forceinline__ void xcd_barrier(const XcdBarrier& b) {
    asm volatile("s_waitcnt vmcnt(0)" ::: "memory");
    __syncthreads();
    if (threadIdx.x == 0) {
        unsigned* bar = b.bar;
        __builtin_amdgcn_s_waitcnt(0);
        unsigned nloc = b.st[0], nx = b.st[1];
        if (nloc == 0u) { xcd_barrier_complete(bar, b.x, nloc, nx); b.st[0] = nloc; b.st[1] = nx; }
        const unsigned old = xb_add(&bar[XB_XSUB(b.x)], 1u);
        const unsigned gen = old / nloc;
        if (old + 1u == (gen + 1u) * nloc) {
            __builtin_amdgcn_fence(__ATOMIC_RELEASE, "agent");
            asm volatile("s_waitcnt vmcnt(0)" ::: "memory");
            const unsigned og = xb_add(&bar[XB_TOP], 1u);
            const unsigned tg = og / nx;
            if (og + 1u == (tg + 1u) * nx) xb_add(&bar[XB_TOPGEN], 1u);
            else XB_SPIN(xb_ld(&bar[XB_TOPGEN]) == tg, bar);
            __builtin_amdgcn_fence(__ATOMIC_ACQUIRE, "agent");
            xb_add(&bar[XB_XGEN(b.x)], 1u);
            asm volatile("s_waitcnt vmcnt(0)" ::: "memory");
        } else {
            XB_SPIN(xb_ld(&bar[XB_XGEN(b.x)]) == gen, bar);
            __builtin_amdgcn_fence(__ATOMIC_ACQUIRE, "agent");
            asm volatile("s_waitcnt vmcnt(0)" ::: "memory");
        }
    }
    __syncthreads();
}

__device__ __forceinline__ void xcd_barrier_arrive(const XcdBarrier& b, volatile LAS unsigned* mb) {
    asm volatile("s_waitcnt vmcnt(0)" ::: "memory");
    __syncthreads();
    if (threadIdx.x == 0) {
        unsigned* bar = b.bar;
        __builtin_amdgcn_s_waitcnt(0);
        unsigned nloc = b.st[0], nx = b.st[1];
        if (nloc == 0u) { xcd_barrier_complete(bar, b.x, nloc, nx); b.st[0] = nloc; b.st[1] = nx; }
        const unsigned old = xb_add(&bar[XB_XSUB(b.x)], 1u);
        const unsigned gen = old / nloc;
        if (old + 1u == (gen + 1u) * nloc) {
            __builtin_amdgcn_fence(__ATOMIC_RELEASE, "agent");
            asm volatile("s_waitcnt vmcnt(0)" ::: "memory");
            const unsigned og = xb_add(&bar[XB_TOP], 1u);
            const unsigned tg = og / nx;
            if (og + 1u == (tg + 1u) * nx) xb_add(&bar[XB_TOPGEN], 1u);
            else XB_SPIN(xb_ld(&bar[XB_TOPGEN]) == tg, bar);
            __builtin_amdgcn_fence(__ATOMIC_ACQUIRE, "agent");
            xb_add(&bar[XB_XGEN(b.x)], 1u);
            asm volatile("s_waitcnt vmcnt(0)" ::: "memory");
            mb[0] = 0u;
        } else { mb[0] = 1u; mb[1] = gen; }
    }
    asm volatile("s_waitcnt lgkmcnt(0)" ::: "memory"); __syncthreads();
}
__device__ __forceinline__ unsigned xcd_released(const XcdBarrier& b, unsigned gen) { return (xb_ld(&b.bar[XB_XGEN(b.x)]) != gen) ? 1u : 0u; }
__device__ __forceinline__ void xcd_wait_release(const XcdBarrier& b, unsigned gen) { XB_SPIN(xb_ld(&b.bar[XB_XGEN(b.x)]) == gen, b.bar); }
__device__ __forceinline__ void xcd_acquire() { __builtin_amdgcn_fence(__ATOMIC_ACQUIRE, "agent"); asm volatile("s_waitcnt vmcnt(0)" ::: "memory"); }

struct Args { const float* in[19]; float* out; unsigned char* ws; int ph_lo, ph_hi; };
static_assert(sizeof(Args) == 19 * 8 + 8 + 8 + 8, "Args has no padding");

__device__ __forceinline__ float wave_sum(float v) {
#pragma unroll
    for (int o = 1; o < 64; o <<= 1) v += __shfl_xor(v, o);
    return v;
}

template <int DEEP = 0>
__device__ __forceinline__ void tr_item(const float* W, int N, bf16* WT, int ldk, int kofs, int rowbase, LAS float* scr, int kb, int nb, int lane, const float* gain = nullptr) {
    const float* src = W + (size_t)(64 * kb) * N + 64 * nb + lane;
    const int c = lane & 7;
    f32x4 ga = (f32x4){1.f, 1.f, 1.f, 1.f}, gb = ga;
    if (gain) { ga = *(const GAS f32x4*)(gain + 64 * kb + 8 * c); gb = *(const GAS f32x4*)(gain + 64 * kb + 8 * c + 4); }
    if (DEEP) { float v[64];
#pragma unroll
        for (int kk = 0; kk < 64; ++kk) v[kk] = __builtin_nontemporal_load(src + (size_t)kk * N);
#pragma unroll
        for (int kk = 0; kk < 64; ++kk) scr[kk * 65 + lane] = v[kk];
    } else {
#pragma unroll 16
        for (int kk = 0; kk < 64; ++kk) scr[kk * 65 + lane] = __builtin_nontemporal_load(src + (size_t)kk * N);
    }
    LDS_WAIT(); asm volatile("" ::: "memory");
#pragma unroll
    for (int j = 0; j < 8; ++j) { const int n = (lane >> 3) + 8 * j; const LAS float* s = scr + (8 * c) * 65 + n;
        v4u o; o.x = cvtpk_c(s[0 * 65] * ga[0], s[1 * 65] * ga[1]); o.y = cvtpk_c(s[2 * 65] * ga[2], s[3 * 65] * ga[3]); o.z = cvtpk_c(s[4 * 65] * gb[0], s[5 * 65] * gb[1]); o.w = cvtpk_c(s[6 * 65] * gb[2], s[7 * 65] * gb[3]);
        if (DEEP) __builtin_nontemporal_store(o, (GAS v4u*)(WT + (size_t)(rowbase + n) * ldk + kofs + 64 * kb + 8 * c)); else *(GAS v4u*)(WT + (size_t)(rowbase + n) * ldk + kofs + 64 * kb + 8 * c) = o; }
    LDS_WAIT(); asm volatile("" ::: "memory");
}
__device__ __forceinline__ void cvt_row_bf16(const float* xrow, bf16* orow, float* ss, int lane) {
    const GAS f32x4* xr = (const GAS f32x4*)xrow + lane;
    f32x4 v[16]; float s = 0.f;
#pragma unroll
    for (int j = 0; j < 16; ++j) { v[j] = __builtin_nontemporal_load(xr + 64 * j); s += (v[j].x * v[j].x + v[j].y * v[j].y) + (v[j].z * v[j].z + v[j].w * v[j].w); }
    s = wave_sum(s);
    GAS v2u* o8 = (GAS v2u*)orow + lane;
#pragma unroll
    for (int j = 0; j < 16; ++j) { v2u w; w.x = cvtpk(v[j].x, v[j].y); w.y = cvtpk(v[j].z, v[j].w); o8[64 * j] = w; }
    if (lane == 0) *ss = s;
}
__device__ __forceinline__ void rms_row_out(const bf16* hrow, float* orow, const float* gain, int lane) {
    const GAS v4u* hr = (const GAS v4u*)hrow + lane; const GAS f32x4* gr = (const GAS f32x4*)gain; GAS f32x4* o4 = (GAS f32x4*)orow;
    v4u w[8]; float s = 0.f;
#pragma unroll
    for (int j = 0; j < 8; ++j) { w[j] = hr[64 * j];
        const float a0 = __uint_as_float(w[j].x << 16), a1 = __uint_as_float(w[j].x & 0xffff0000u), a2 = __uint_as_float(w[j].y << 16), a3 = __uint_as_float(w[j].y & 0xffff0000u);
        const float a4 = __uint_as_float(w[j].z << 16), a5 = __uint_as_float(w[j].z & 0xffff0000u), a6 = __uint_as_float(w[j].w << 16), a7 = __uint_as_float(w[j].w & 0xffff0000u);
        s += (a0 * a0 + a1 * a1) + (a2 * a2 + a3 * a3) + (a4 * a4 + a5 * a5) + (a6 * a6 + a7 * a7); }
    const float rstd = 1.0f / sqrtf(wave_sum(s) * (1.f / DM) + RMS_EPS);
#pragma unroll
    for (int j = 0; j < 8; ++j) { const int e = (64 * j + lane) * 2;
        const f32x4 g0 = gr[e], g1 = gr[e + 1]; f32x4 o0, o1;
        o0[0] = __uint_as_float(w[j].x << 16) * rstd * g0[0]; o0[1] = __uint_as_float(w[j].x & 0xffff0000u) * rstd * g0[1]; o0[2] = __uint_as_float(w[j].y << 16) * rstd * g0[2]; o0[3] = __uint_as_float(w[j].y & 0xffff0000u) * rstd * g0[3];
        o1[0] = __uint_as_float(w[j].z << 16) * rstd * g1[0]; o1[1] = __uint_as_float(w[j].z & 0xffff0000u) * rstd * g1[1]; o1[2] = __uint_as_float(w[j].w << 16) * rstd * g1[2]; o1[3] = __uint_as_float(w[j].w & 0xffff0000u) * rstd * g1[3];
        o4[e] = o0; o4[e + 1] = o1; }
}

namespace att {
constexpr int LD = 2 * HD, LDO = DM;
constexpr int SHM_V = 16384, SHM_K = 16384;
constexpr int NSLOT = 3, OFF_V = 0, OFF_K = NSLOT * SHM_V, OFF_WS = NSLOT * (SHM_V + SHM_K), OFF_FLAG = OFF_WS + NWAVES * 256, OFF_KMS = OFF_FLAG + 64;
#define KSWZ(row, colB) ((row) * 256 + ((colB) ^ (((row) & 7) << 4)))
__device__ __forceinline__ int v_st(int k, int c) { const int kk = (k & ~0xC) | ((k & 4) << 1) | ((k & 8) >> 1); return ((kk >> 3) * 4 + (c >> 5)) * 512 + ((kk & 7) * 32 + (c & 31)) * 2; }
__device__ __forceinline__ int v_rd_base(int lane) { return ((lane & 3) << 3) | (((lane >> 2) & 3) << 6) | (((lane >> 4) & 1) << 5) | (((lane >> 5) & 1) << 8); }
constexpr int v_rd_off(int d0, int ks, int half) { return d0 * 512 + ks * 4096 + half * 2048; }
__device__ __forceinline__ int crow(int r, int hi) { return (r & 3) + 8 * (r >> 2) + 4 * hi; }
__device__ __forceinline__ float pmaxswap(float v) { auto rr = __builtin_amdgcn_permlane32_swap(__float_as_uint(v), __float_as_uint(v), false, false); return fmaxf(__uint_as_float(rr[0]), __uint_as_float(rr[1])); }
__device__ __forceinline__ float psumswap(float v) { auto rr = __builtin_amdgcn_permlane32_swap(__float_as_uint(v), __float_as_uint(v), false, false); return __uint_as_float(rr[0]) + __uint_as_float(rr[1]); }

__device__ __forceinline__ void qkt(f32x16& p0, f32x16& p1, LAS const char* Kbuf, int r32, int hi, const bf16x8* qr) {
    p0 = f32x16{}; p1 = f32x16{};
    LAS const char* kb[4];
#pragma unroll
    for (int dd = 0; dd < 4; ++dd) kb[dd] = Kbuf + KSWZ(r32, (dd * 16 + hi * 8) * 2);
#pragma unroll
    for (int d0 = 0; d0 < 8; ++d0) { LAS const char* a = kb[d0 & 3] + (d0 >> 2) * 128;
        const bf16x8 b0 = *(LAS const bf16x8*)a; const bf16x8 b1 = *(LAS const bf16x8*)(a + 32 * 256);
        p0 = __builtin_amdgcn_mfma_f32_32x32x16_bf16(b0, qr[d0], p0, 0, 0, 0);
        p1 = __builtin_amdgcn_mfma_f32_32x32x16_bf16(b1, qr[d0], p1, 0, 0, 0); }
}
__device__ __forceinline__ void pv_tile(f32x16* o, int vb, bf16x8 pa0, bf16x8 pa1, bf16x8 pa2, bf16x8 pa3) {
#define TRRD(dst, off) asm volatile("ds_read_b64_tr_b16 %0, %1 offset:%2" : "=&v"(dst) : "v"(vb), "i"(off) : "memory")
#define PV_RD(S, d0) do { constexpr int b_ = v_rd_off(d0, 0, 0); \
        TRRD(S##l0, b_); TRRD(S##h0, b_ + 2048); TRRD(S##l1, b_ + 4096); TRRD(S##h1, b_ + 6144); TRRD(S##l2, b_ + 8192); TRRD(S##h2, b_ + 10240); TRRD(S##l3, b_ + 12288); TRRD(S##h3, b_ + 14336); } while (0)
#define PV_MM(S, d0) do { \
        o[d0] = __builtin_amdgcn_mfma_f32_32x32x16_bf16(pa0, (bf16x8){S##l0[0], S##l0[1], S##l0[2], S##l0[3], S##h0[0], S##h0[1], S##h0[2], S##h0[3]}, o[d0], 0, 0, 0); \
        o[d0] = __builtin_amdgcn_mfma_f32_32x32x16_bf16(pa1, (bf16x8){S##l1[0], S##l1[1], S##l1[2], S##l1[3], S##h1[0], S##h1[1], S##h1[2], S##h1[3]}, o[d0], 0, 0, 0); \
        o[d0] = __builtin_amdgcn_mfma_f32_32x32x16_bf16(pa2, (bf16x8){S##l2[0], S##l2[1], S##l2[2], S##l2[3], S##h2[0], S##h2[1], S##h2[2], S##h2[3]}, o[d0], 0, 0, 0); \
        o[d0] = __builtin_amdgcn_mfma_f32_32x32x16_bf16(pa3, (bf16x8){S##l3[0], S##l3[1], S##l3[2], S##l3[3], S##h3[0], S##h3[1], S##h3[2], S##h3[3]}, o[d0], 0, 0, 0); } while (0)
    s16x4 Al0, Al1, Al2, Al3, Ah0, Ah1, Ah2, Ah3, Bl0, Bl1, Bl2, Bl3, Bh0, Bh1, Bh2, Bh3;
    PV_RD(A, 0);
    PV_RD(B, 1); asm volatile("s_waitcnt lgkmcnt(8)" ::: "memory"); SBAR(); PV_MM(A, 0); SBAR();
    PV_RD(A, 2); asm volatile("s_waitcnt lgkmcnt(8)" ::: "memory"); SBAR(); PV_MM(B, 1); SBAR();
    PV_RD(B, 3); asm volatile("s_waitcnt lgkmcnt(8)" ::: "memory"); SBAR(); PV_MM(A, 2); SBAR();
    asm volatile("s_waitcnt lgkmcnt(0)" ::: "memory"); SBAR(); PV_MM(B, 3);
#undef PV_MM
#undef PV_RD
#undef TRRD
}
__device__ __forceinline__ void pack_p(const f32x16& p0, const f32x16& p1, bf16x8& pa0, bf16x8& pa1, bf16x8& pa2, bf16x8& pa3) {
#define PK4(P, B_, OUT) do { unsigned a0 = cvtpk(P[B_+0], P[B_+1]), a1 = cvtpk(P[B_+2], P[B_+3]); \
        unsigned b0 = cvtpk(P[B_+4], P[B_+5]), b1 = cvtpk(P[B_+6], P[B_+7]); \
        auto r0 = __builtin_amdgcn_permlane32_swap(a0, b0, false, false); auto r1 = __builtin_amdgcn_permlane32_swap(a1, b1, false, false); \
        v4u w = {r0[0], r1[0], r0[1], r1[1]}; OUT = *reinterpret_cast<bf16x8*>(&w); } while (0)
    PK4(p0, 0, pa0); PK4(p0, 8, pa1); PK4(p1, 0, pa2); PK4(p1, 8, pa3);
#undef PK4
}

template <int MODE>
__device__ __forceinline__ void attn_unit(const bf16* Qg, const bf16* Kg, const bf16* Vg, bf16* Og, int qb, float slope, const float* KMg, const float* KNg, LAS char* lds) {
    const int tid = threadIdx.x, wid = __builtin_amdgcn_readfirstlane(tid >> 6), lane = tid & 63, r32 = lane & 31, hi = lane >> 5;
    const int t0 = qb * 256 + wid * 32, trow = t0 + r32;
    LAS float* wsf = (LAS float*)(lds + OFF_WS) + wid * 64; LAS float* li_l = wsf;
    volatile LAS int* flags = (volatile LAS int*)(lds + OFF_FLAG);
    const int vb0 = (int)(size_t)(lds + OFF_V) + v_rd_base(lane);
    constexpr float LOG2E = 1.4426950408889634f, SCALE = 0.08838834764831845f, C2 = LOG2E * SCALE;
    bf16x8 qr[8];
#pragma unroll
    for (int d0 = 0; d0 < 8; ++d0) qr[d0] = *(const GAS bf16x8*)(Qg + (size_t)trow * LD + d0 * 16 + hi * 8);
    unsigned selmask = 0u;
    if (MODE == 0) {
        if (qb <= 3) selmask = (1u << qb) - 1u;
        else {
            const int nrow = (r32 & 3) + 4 * (r32 >> 3);
            f32x16 g = f32x16{};
#pragma unroll
            for (int d0 = 0; d0 < 8; ++d0) {
                f32x4 a = (f32x4){0.f, 0.f, 0.f, 0.f}, b = a;
                if (nrow < qb) { const GAS f32x4* kp = (const GAS f32x4*)(KMg + nrow * HD + d0 * 16 + hi * 8); a = kp[0]; b = kp[1]; }
                v4u whi, wlo;
                whi.x = cvtpk(a[0], a[1]); whi.y = cvtpk(a[2], a[3]); whi.z = cvtpk(b[0], b[1]); whi.w = cvtpk(b[2], b[3]);
                wlo.x = cvtpk(a[0] - __uint_as_float(whi.x << 16), a[1] - __uint_as_float(whi.x & 0xffff0000u)); wlo.y = cvtpk(a[2] - __uint_as_float(whi.y << 16), a[3] - __uint_as_float(whi.y & 0xffff0000u));
                wlo.z = cvtpk(b[0] - __uint_as_float(whi.z << 16), b[1] - __uint_as_float(whi.z & 0xffff0000u)); wlo.w = cvtpk(b[2] - __uint_as_float(whi.w << 16), b[3] - __uint_as_float(whi.w & 0xffff0000u));
                g = __builtin_amdgcn_mfma_f32_32x32x16_bf16(*reinterpret_cast<bf16x8*>(&whi), qr[d0], g, 0, 0, 0);
                g = __builtin_amdgcn_mfma_f32_32x32x16_bf16(*reinterpret_cast<bf16x8*>(&wlo), qr[d0], g, 0, 0, 0);
            }
#pragma unroll
            for (int pick = 0; pick < 3; ++pick) { float best = -__builtin_inff(); int bi = -1;
#pragma unroll
                for (int n = 0; n < 16; ++n) { const bool cand = (n < qb) && !((selmask >> n) & 1u); if (cand && (bi < 0 || g[n] > best)) { best = g[n]; bi = n; } }
                if (bi >= 0) selmask |= 1u << bi; }
        }
    }
    const float sl2 = slope * LOG2E;
    float mrow = 0.f, mrow_w = 0.f;
    if (MODE == 0) {
        float qn = 0.f;
#pragma unroll
        for (int d0 = 0; d0 < 8; ++d0)
#pragma unroll
            for (int j = 0; j < 8; ++j) { const float v = __uint_as_float(((unsigned)(unsigned short)qr[d0][j]) << 16); qn += v * v; }
        qn = psumswap(qn);
        float kn = 0.f;
        for (int n = 0; n <= qb; ++n) kn = fmaxf(kn, KNg[n]);
        mrow = C2 * sqrtf(qn) * sqrtf(kn) * 1.001f;
        mrow_w = mrow;
#pragma unroll
        for (int o_ = 1; o_ < 64; o_ <<= 1) mrow_w = fmaxf(mrow_w, __shfl_xor(mrow_w, o_));
    }
    float l_reg = 0.f, carry = 0.f; f32x16 o[4] = {};
    bool done = false;
    const int NT = 4 * (qb + 1);
    int gofK[2], gofV[2];
#pragma unroll
    for (int i = 0; i < 2; ++i) { const int pi = wid * 2 + i;
        { const int row = pi * 4 + (lane >> 4), colB = (16 * (lane & 15)) ^ ((row & 7) << 4); gofK[i] = row * LD + (colB >> 1); }
        { const int sub = 2 * pi + (lane >> 5), kk = (sub >> 2) * 8 + ((lane & 31) >> 2), c = (sub & 3) * 32 + 8 * (lane & 3), k = (kk & ~0xC) | ((kk & 4) << 1) | ((kk & 8) >> 1); gofV[i] = k * LD + c; } }
#define TDMA(jt_) do { const int sl_ = (jt_) % NSLOT; const bf16* kt_ = Kg + (size_t)(jt_) * 64 * LD; const bf16* vt_ = Vg + (size_t)(jt_) * 64 * LD; \
        _Pragma("unroll") for (int i_ = 0; i_ < 2; ++i_) { \
            __builtin_amdgcn_global_load_lds((const unsigned*)(kt_ + gofK[i_]), (LAS unsigned*)(lds + OFF_K + sl_ * SHM_K + (wid * 2 + i_) * 1024), 16, 0, 0); \
            __builtin_amdgcn_global_load_lds((const unsigned*)(vt_ + gofV[i_]), (LAS unsigned*)(lds + OFF_V + sl_ * SHM_V + (wid * 2 + i_) * 1024), 16, 0, 0); } } while (0)
    TDMA(NT - 1); TDMA(NT - 2);
    asm volatile("s_waitcnt vmcnt(4)" ::: "memory");
    __builtin_amdgcn_s_barrier(); asm volatile("" ::: "memory");
    for (int jt = NT - 1; jt >= 0; --jt) {
        const int buf = jt % NSLOT;
        if (jt >= 2) TDMA(jt - 2);
        const int kb = jt * 64;
        bool act = (kb <= t0 + 31) && !done;
        const int nblk = jt >> 2;
        if (MODE == 0 && nblk < qb) act = act && __any((selmask >> nblk) & 1u);
        if (act) {
            f32x16 p0, p1;
            qkt(p0, p1, (LAS const char*)(lds + OFF_K + buf * SHM_K), r32, hi, qr);
            const int dq = trow - kb - 4 * hi;
            if (MODE == 0) {
                const bool sel = (nblk >= qb) || ((selmask >> nblk) & 1u);
                const float A0 = sel ? (-sl2 * (float)dq - mrow) : -__builtin_inff();
#pragma unroll
                for (int r = 0; r < 16; ++r) { const int c = (r & 3) + 8 * (r >> 2); const float B = A0 + sl2 * (float)c; p0[r] = fmaf(p0[r], C2, B); p1[r] = fmaf(p1[r], C2, B + 32.f * sl2); }
                if (kb + 63 > t0) {
#pragma unroll
                    for (int r = 0; r < 16; ++r) { const int c = (r & 3) + 8 * (r >> 2); if (c > dq) p0[r] = -__builtin_inff(); if (c + 32 > dq) p1[r] = -__builtin_inff(); }
                }
                float ps = 0.f;
#pragma unroll
                for (int r = 0; r < 16; ++r) { p0[r] = __builtin_amdgcn_exp2f(p0[r]); ps += p0[r]; }
#pragma unroll
                for (int r = 0; r < 16; ++r) { p1[r] = __builtin_amdgcn_exp2f(p1[r]); ps += p1[r]; }
                l_reg += psumswap(ps);
            } else {
                f32x16 k0, k1;
#pragma unroll
                for (int r = 0; r < 16; ++r) { const int c = (r & 3) + 8 * (r >> 2);
                    { const float z2 = p0[r] * C2; const float sp = fmaxf(z2, 0.f) + __builtin_amdgcn_logf(1.0f + __builtin_amdgcn_exp2f(-fabsf(z2))); const bool v = c < dq; k0[r] = v ? -sp : 0.f; p0[r] = v ? z2 - sp : -__builtin_inff(); }
                    { const float z2 = p1[r] * C2; const float sp = fmaxf(z2, 0.f) + __builtin_amdgcn_logf(1.0f + __builtin_amdgcn_exp2f(-fabsf(z2))); const bool v = c + 32 < dq; k1[r] = v ? -sp : 0.f; p1[r] = v ? z2 - sp : -__builtin_inff(); } }
                float T0[4], T1[4];
#pragma unroll
                for (int g = 0; g < 4; ++g) {
                    { const float a3 = k0[4 * g + 3], a2 = k0[4 * g + 2], a1 = k0[4 * g + 1], a0 = k0[4 * g]; const float e2 = a3, e1 = e2 + a2, e0 = e1 + a1; T0[g] = e0 + a0; k0[4 * g + 3] = 0.f; k0[4 * g + 2] = e2; k0[4 * g + 1] = e1; k0[4 * g] = e0; }
                    { const float a3 = k1[4 * g + 3], a2 = k1[4 * g + 2], a1 = k1[4 * g + 1], a0 = k1[4 * g]; const float e2 = a3, e1 = e2 + a2, e0 = e1 + a1; T1[g] = e0 + a0; k1[4 * g + 3] = 0.f; k1[4 * g + 2] = e2; k1[4 * g + 1] = e1; k1[4 * g] = e0; }
                }
                float P0[4], P1[4];
#pragma unroll
                for (int g = 0; g < 4; ++g) { P0[g] = __shfl_xor(T0[g], 32); P1[g] = __shfl_xor(T1[g], 32); }
                float R1[4], R0[4];
                R1[3] = 0.f; R1[2] = T1[3] + P1[3]; R1[1] = R1[2] + (T1[2] + P1[2]); R1[0] = R1[1] + (T1[1] + P1[1]); const float tot1 = R1[0] + (T1[0] + P1[0]);
                R0[3] = 0.f; R0[2] = T0[3] + P0[3]; R0[1] = R0[2] + (T0[2] + P0[2]); R0[0] = R0[1] + (T0[1] + P0[1]); const float tot0 = R0[0] + (T0[0] + P0[0]);
#pragma unroll
                for (int g = 0; g < 4; ++g) {
                    const float off1 = carry + R1[g] + (hi == 0 ? P1[g] : 0.f), off0 = carry + tot1 + R0[g] + (hi == 0 ? P0[g] : 0.f);
#pragma unroll
                    for (int i = 0; i < 4; ++i) { p0[4 * g + i] = __builtin_amdgcn_exp2f(p0[4 * g + i] + k0[4 * g + i] + off0); p1[4 * g + i] = __builtin_amdgcn_exp2f(p1[4 * g + i] + k1[4 * g + i] + off1); }
                }
                carry += tot0 + tot1;
                if (__all(carry < -150.1f)) done = true;
            }
            bf16x8 pa0, pa1, pa2, pa3;
            pack_p(p0, p1, pa0, pa1, pa2, pa3);
            pv_tile(o, vb0 + buf * SHM_V, pa0, pa1, pa2, pa3);
        }
        bool stop = false;
        if (MODE == 0 && jt >= 1 && 2.f * mrow_w - sl2 * (float)(t0 - (jt - 1) * 64 - 63) < -150.5f) done = true;
        if (lane == 0) flags[(jt & 1) * 8 + wid] = done ? 1 : 0;
        if (jt >= 2) asm volatile("s_waitcnt vmcnt(4) lgkmcnt(0)" ::: "memory"); else asm volatile("s_waitcnt vmcnt(0) lgkmcnt(0)" ::: "memory");
        __builtin_amdgcn_s_barrier(); asm volatile("" ::: "memory");
        { int all = 1;
#pragma unroll
            for (int w = 0; w < 8; ++w) all &= flags[(jt & 1) * 8 + w];
            stop = (all != 0); }
        if (stop) break;
    }
    asm volatile("s_waitcnt vmcnt(0)" ::: "memory");
#undef TDMA
    float rli[16];
    if (MODE == 0) { if (hi == 0) li_l[r32] = l_reg; LDS_WAIT();
#pragma unroll
        for (int r = 0; r < 16; ++r) rli[r] = __builtin_amdgcn_rcpf(li_l[crow(r, hi)]); }
    bf16* Ow = Og + (size_t)t0 * LDO;
#pragma unroll
    for (int r = 0; r < 16; ++r) { const int orow = crow(r, hi);
#pragma unroll
        for (int d0 = 0; d0 < 4; ++d0) { const float v = (MODE == 0) ? o[d0][r] * rli[r] : o[d0][r];
            *(GAS unsigned short*)(Ow + (size_t)orow * LDO + d0 * 32 + r32) = (unsigned short)cvtpk_c(v, v); } }
    LDS_WAIT();
    __syncthreads();
}
}

__global__ void __launch_bounds__(NWAVES * 64, 2) mega_fwd(Args args) {
    extern __shared__ __attribute__((aligned(16))) unsigned char lds_raw[];
    LAS unsigned char* lds = (LAS unsigned char*)lds_raw;
    volatile LAS unsigned* MISC = (volatile LAS unsigned*)(lds + MISC_OFF);
    const int tid = threadIdx.x, lane = tid & 63, wave = __builtin_amdgcn_readfirstlane(tid >> 6);
    const int G = gridDim.x, bid = blockIdx.x;
    unsigned char* ws = args.ws;
    gu32* ctl = (gu32*)(ws + WS_CTL);
    const float* x = args.in[0]; const float* pin = args.in[1];
    const float* g_ffn1 = args.in[2]; const float* w_g1 = args.in[3]; const float* w_u1 = args.in[4]; const float* w_d1 = args.in[5];
    const float* g_mix = args.in[6]; const float* w_in = args.in[7]; const float* w_bA = args.in[8]; const float* w_bB = args.in[9]; const float* w_out = args.in[10];
    const float* g_ffn2 = args.in[11]; const float* w_g2 = args.in[12]; const float* w_u2 = args.in[13]; const float* w_d2 = args.in[14];
    const float* g_ple = args.in[15]; const float* w_pg = args.in[16]; const float* w_pe = args.in[17]; const float* g_fin = args.in[18];
    float* out = args.out;
    bf16* WGU1 = (bf16*)(ws + WS_WGU1); bf16* WD1 = (bf16*)(ws + WS_WD1); bf16* WIN = (bf16*)(ws + WS_WIN); bf16* WBR = (bf16*)(ws + WS_WBR); bf16* WOUT = (bf16*)(ws + WS_WOUT);
    bf16* WGU2 = (bf16*)(ws + WS_WGU2); bf16* WD2 = (bf16*)(ws + WS_WD2); bf16* WPG = (bf16*)(ws + WS_WPG); bf16* WPE = (bf16*)(ws + WS_WPE);
    bf16* PBF = (bf16*)(ws + WS_PBF); bf16* XB = (bf16*)(ws + WS_XBZ); bf16* Z = XB; bf16* HF = XB;     bf16* HB = (bf16*)(ws + WS_HB); bf16* ATT = (bf16*)(ws + WS_ATT); bf16* PE = (bf16*)args.out;
    bf16* QKV = (bf16*)(ws + WS_R1); bf16* GAB = QKV + (size_t)6 * M * AW; bf16* ACT = (bf16*)(ws + WS_R1);
    float* SS0 = (float*)(ws + WS_SS0); float* SS1 = (float*)(ws + WS_SS1); float* SS2 = (float*)(ws + WS_SS2); float* SS3 = (float*)(ws + WS_SS3);
    float* KM = (float*)(ws + WS_KM); float* KN = (float*)(ws + WS_KM + 512 * 1024);

    for (int u = tid; u < (LDS_BYTES - LDSCTL_OFF) / 4; u += NWAVES * 64) ((LAS unsigned*)(lds + LDSCTL_OFF))[u] = 0u;
    __syncthreads();
    XcdBarrier bar; bar.bar = (unsigned*)(ctl + CW_BAR); bar.x = 0; bar.st = nullptr;
    if (MK_N_LAUNCHES == 1) bar = xcd_barrier_post((unsigned*)(ctl + CW_BAR), MISC + 8);
    const int lo = args.ph_lo, hi = args.ph_hi;
#define IN(k) (lo <= (k) && (k) < hi)
#define SEAM(k) do { if (IN(k) && IN((k) + 1)) xcd_barrier(bar); } while (0)
    const int gw = bid * NWAVES + wave, NGW = G * NWAVES;
    LAS float* rsl = (LAS float*)(lds + LDSCTL_OFF + 1024);
#define PREP_RS(RSV, SSp, S_) pg8::RowScale RSV{SSp, rsl, -1}; do { pg8::Unit u0_; if (S_.next(0, u0_)) { RSV.pm0 = u0_.pm; if (tid < 256) rsl[tid] = __builtin_amdgcn_rsqf(SSp[u0_.pm * 256 + tid] * (1.0f / DM) + RMS_EPS); } LDS_WAIT(); __syncthreads(); } while (0)

    constexpr int I_GU = (DM / 64) * (DFF / 64), I_D = (DFF / 64) * (DM / 64), I_IN = (DM / 64) * (INC / 64), I_BR = (AW / 64) * (DM / 64), I_SQ = (DM / 64) * (DM / 64), I_PE = (PLE / 64) * (DM / 64);
    constexpr int NITEMS = 4 * I_GU + 2 * I_D + I_IN + 2 * I_BR + 2 * I_SQ + I_PE;
    const bool tailfill = (G == 256);
#define CONV_ITEM(it_) do { int r = (it_); LAS float* scr = (LAS float*)(lds + RING_OFF + wave * 16640);     \
        if (r < 4 * I_GU) { const int which = r / I_GU; r -= which * I_GU; const int nbn = DFF / 64, kb = r / nbn, nb = r % nbn; const int n0 = 64 * nb;     \
            const float* W = which == 0 ? w_g1 : which == 1 ? w_u1 : which == 2 ? w_g2 : w_u2; bf16* WT = which < 2 ? WGU1 : WGU2; \
            tr_item(W, DFF, WT, DM, 0, (n0 >> 7) * 256 + (n0 & 127) + (which & 1) * 128, scr, kb, nb, lane, which < 2 ? g_ffn1 : g_ffn2); break; } \
        r -= 4 * I_GU; \
        if (r < 2 * I_D) { const int which = r / I_D; r -= which * I_D; const int nbn = DM / 64, kb = r / nbn, nb = r % nbn; \
            tr_item(which ? w_d2 : w_d1, DM, which ? WD2 : WD1, DFF, 0, 64 * nb, scr, kb, nb, lane); break; } \
        r -= 2 * I_D; \
        if (r < I_IN) { const int nbn = INC / 64, kb = r / nbn, nb = r % nbn; tr_item(w_in, INC, WIN, DM, 0, 64 * nb, scr, kb, nb, lane, g_mix); break; } \
        r -= I_IN; \
        if (r < 2 * I_BR) { const int which = r / I_BR; r -= which * I_BR; const int nbn = DM / 64, kb = r / nbn, nb = r % nbn; \
            tr_item(which ? w_bB : w_bA, DM, WBR, 2 * AW, which * AW, 64 * nb, scr, kb, nb, lane); break; } \
        r -= 2 * I_BR; \
        if (r < 2 * I_SQ) { const int which = r / I_SQ; r -= which * I_SQ; const int nbn = DM / 64, kb = r / nbn, nb = r % nbn; \
            tr_item(which ? w_pg : w_out, DM, which ? WPG : WOUT, DM, 0, 64 * nb, scr, kb, nb, lane, which ? g_ple : nullptr); break; } \
        r -= 2 * I_SQ; \
        { const int nbn = DM / 64, kb = r / nbn, nb = r % nbn; tr_item(w_pe, DM, WPE, PLE, 0, 64 * nb, scr, kb, nb, lane); } } while (0)
    constexpr int N_LATE = I_D + I_IN + 2 * I_BR + I_SQ + 2 * I_GU + I_D + I_SQ, NT_BG = N_LATE / 8, N_EARLY = NITEMS - N_LATE;
    constexpr int T_D1 = I_D / 8, T_IN = T_D1 + I_IN / 8, T_BR = T_IN + 2 * I_BR / 8, T_OUT = T_BR + I_SQ / 8, T_GU2 = T_OUT + 2 * I_GU / 8, T_D2 = T_GU2 + I_D / 8;
    static_assert(N_LATE % 8 == 0 && I_D % 8 == 0 && I_IN % 8 == 0 && (2 * I_BR) % 8 == 0 && I_SQ % 8 == 0, "tickets of 8 tiles, groups on ticket boundaries");
#define BG_CONV(j_) do { int q = (j_); LAS float* scr = (LAS float*)(lds + RING_OFF + wave * 16640); \
        const float* W_; int N_; bf16* WT_; int ldk_, kofs_ = 0, rowbase_, kb_, nb_; const float* gain_ = nullptr; \
        if (q < I_D) { const int nbn = DM / 64; kb_ = q / nbn; nb_ = q % nbn; W_ = w_d1; N_ = DM; WT_ = WD1; ldk_ = DFF; rowbase_ = 64 * nb_; } \
        else if ((q -= I_D) < I_IN) { const int nbn = INC / 64; kb_ = q / nbn; nb_ = q % nbn; W_ = w_in; N_ = INC; WT_ = WIN; ldk_ = DM; rowbase_ = 64 * nb_; gain_ = g_mix; } \
        else if ((q -= I_IN) < 2 * I_BR) { const int which = q / I_BR; q -= which * I_BR; const int nbn = DM / 64; kb_ = q / nbn; nb_ = q % nbn; W_ = which ? w_bB : w_bA; N_ = DM; WT_ = WBR; ldk_ = 2 * AW; kofs_ = which * AW; rowbase_ = 64 * nb_; } \
        else if ((q -= 2 * I_BR) < I_SQ) { const int nbn = DM / 64; kb_ = q / nbn; nb_ = q % nbn; W_ = w_out; N_ = DM; WT_ = WOUT; ldk_ = DM; rowbase_ = 64 * nb_; } \
        else if ((q -= I_SQ) < 2 * I_GU) { const int which = 2 + q / I_GU; q -= (which - 2) * I_GU; const int nbn = DFF / 64; kb_ = q / nbn; nb_ = q % nbn; const int n0 = 64 * nb_;     \
            W_ = which == 2 ? w_g2 : w_u2; N_ = DFF; WT_ = WGU2; ldk_ = DM; rowbase_ = (n0 >> 7) * 256 + (n0 & 127) + (which & 1) * 128; gain_ = g_ffn2; } \
        else if ((q -= 2 * I_GU) < I_D) { const int nbn = DM / 64; kb_ = q / nbn; nb_ = q % nbn; W_ = w_d2; N_ = DM; WT_ = WD2; ldk_ = DFF; rowbase_ = 64 * nb_; } \
        else { q -= I_D; const int nbn = DM / 64; kb_ = q / nbn; nb_ = q % nbn; W_ = w_pg; N_ = DM; WT_ = WPG; ldk_ = DM; rowbase_ = 64 * nb_; gain_ = g_ple; } \
        tr_item<1>(W_, N_, WT_, ldk_, kofs_, rowbase_, scr, kb_, nb_, lane, gain_); } while (0)
#define TRY_BG(more_) do { if (tid == 0) MISC[17] = __hip_atomic_fetch_add(ctl + CW_BG, 1u, RLX_AGENT);     \
        LDS_WAIT(); __syncthreads(); const unsigned t_ = MISC[17]; __syncthreads(); \
        more_ = t_ < (unsigned)NT_BG; if (more_) BG_CONV((int)t_ * 8 + wave); } while (0)
#define DRAIN_BG(T_) do { for (;;) { if (tid == 0) { const unsigned c_ = __hip_atomic_load(ctl + CW_BG, RLX_AGENT); MISC[17] = (c_ >= (unsigned)(T_)) ? 0xffffffffu : __hip_atomic_fetch_add(ctl + CW_BG, 1u, RLX_AGENT); } \
        LDS_WAIT(); __syncthreads(); const unsigned t_ = MISC[17]; __syncthreads(); if (t_ >= (unsigned)NT_BG) break; BG_CONV((int)t_ * 8 + wave); if (t_ >= (unsigned)(T_)) break; } } while (0)
#define SEAM_BG(k) do { if (IN(k) && IN((k) + 1)) { if (MK_N_LAUNCHES != 1) { xcd_barrier(bar); break; } \
        xcd_barrier_arrive(bar, MISC + 18); \
        if (MISC[18] != 0u) { const unsigned gen_ = MISC[19]; \
            for (;;) { if (tid == 0) MISC[20] = xcd_released(bar, gen_); LDS_WAIT(); __syncthreads(); const unsigned rel_ = MISC[20]; __syncthreads(); if (rel_) break; \
                bool more_; TRY_BG(more_); if (!more_) { if (tid == 0) xcd_wait_release(bar, gen_); break; } } \
            if (tid == 0) xcd_acquire(); } \
        __syncthreads(); } } while (0)
    if (IN(0)) {
#pragma unroll 1
        for (int it = gw; it < N_EARLY; it += NGW) { int e = N_EARLY - 1 - it, ridx;
            if (e < 2 * I_GU) ridx = e; else ridx = 4 * I_GU + 2 * I_D + I_IN + 2 * I_BR + 2 * I_SQ + (e - 2 * I_GU);
            CONV_ITEM(ridx); }
        for (int m = gw; m < M; m += NGW) cvt_row_bf16(x + (size_t)m * DM, XB + (size_t)m * DM, SS0 + m, lane);
        for (int i = bid * 512 + tid; i < M * PLE / 8; i += G * 512) { const GAS f32x4* s = (const GAS f32x4*)pin + 2 * (size_t)i; const f32x4 a = s[0], b = s[1];
            v4u w; w.x = cvtpk(a.x, a.y); w.y = cvtpk(a.z, a.w); w.z = cvtpk(b.x, b.y); w.w = cvtpk(b.z, b.w); ((GAS v4u*)PBF)[i] = w; }
    }
    SEAM(0);
    if (IN(1)) {
        pg8::Gemm g{XB, WGU1, M, 2 * DFF, DM, DM, DM}; pg8::StaticOrder S; S.init(M, 2 * DFF, G, bid, WGM_ALL);
        PREP_RS(RS, SS0, S); pg8::EpiSwiGLU E{ACT, DFF, RS};
        pg8::gemm_phase<pg8::EpiSwiGLU, pg8::StaticOrder, PG8_ALIGN, PG8_SP2>(lds + RING_OFF, g, S, E);
        if (tailfill && bid >= 128) {
            pg8::Gemm gp{PBF, WPE, M, DM, PLE, PLE, PLE}; pg8::StaticOrder Sp; Sp.init(M, DM, 128, bid - 128, WGM_ALL); Sp.Lend = 256;
            pg8::EpiBf16 Ep{PE, DM, pg8::RowScale{nullptr, rsl, -1}, 256, 1 << 30, nullptr, 0};
            pg8::gemm_phase<pg8::EpiBf16, pg8::StaticOrder, PG8_ALIGN, PG8_SP2>(lds + RING_OFF, gp, Sp, Ep);
        }
    }
    if (IN(1)) DRAIN_BG(T_D1);
    SEAM_BG(1);
    if (IN(2)) {
        pg8::Gemm g{ACT, WD1, M, DM, DFF, DFF, DFF}; g.krev = 1; pg8::StaticOrder S; S.init(M, DM, G, bid, WGM_DOWN);
        pg8::EpiResidBf E{XB, HB, DM, 0.5f, SS1};
        pg8::gemm_phase<pg8::EpiResidBf, pg8::StaticOrder, PG8_ALIGN, PG8_SP2>(lds + RING_OFF, g, S, E);
    }
    if (IN(2)) DRAIN_BG(T_IN);
    SEAM_BG(2);
    if (IN(3)) {
        pg8::Gemm g{HB, WIN, M, INC, DM, DM, DM}; pg8::StaticOrder S; S.init(M, INC, G, bid, WGM_ALL);
        PREP_RS(RS, SS1, S); pg8::EpiBf16 E{QKV, 2 * HD, RS, (size_t)M * 2 * HD, 48, GAB, 2 * DM};
        pg8::gemm_phase<pg8::EpiBf16, pg8::StaticOrder, PG8_ALIGN, PG8_SP2>(lds + RING_OFF, g, S, E);
    }
    SEAM_BG(3);
    if (IN(4)) {
        LAS float* part = (LAS float*)(lds + RING_OFF);
        for (int u = bid; u < BATCH * NH * NBLK; u += G) {
            const int bh = u / NBLK, n = u % NBLK, b = bh / NH, h = bh % NH;
            const bf16* KAh = QKV + ((size_t)(1 * 8 + (h >> 1)) * M + (size_t)b * SEQ) * 2 * HD + (h & 1) * HD;
            const bf16* kp = KAh + (size_t)(n * MB + wave * 32) * 2 * HD + 2 * lane;
            float s0 = 0.f, s1 = 0.f;
#pragma unroll 8
            for (int r = 0; r < 32; ++r) { const unsigned w = *(const GAS unsigned*)(kp + (size_t)r * 2 * HD); s0 += __uint_as_float(w << 16); s1 += __uint_as_float(w & 0xffff0000u); }
            part[wave * 128 + 2 * lane] = s0; part[wave * 128 + 2 * lane + 1] = s1;
            { const bf16* rp = KAh + (size_t)(n * MB + wave * 32 + (lane >> 1)) * 2 * HD + (lane & 1) * 64; float q2 = 0.f;
#pragma unroll
              for (int j = 0; j < 8; ++j) { const v4u w4 = *(const GAS v4u*)(rp + 8 * j);
                  q2 += __uint_as_float(w4.x << 16) * __uint_as_float(w4.x << 16) + __uint_as_float(w4.x & 0xffff0000u) * __uint_as_float(w4.x & 0xffff0000u);
                  q2 += __uint_as_float(w4.y << 16) * __uint_as_float(w4.y << 16) + __uint_as_float(w4.y & 0xffff0000u) * __uint_as_float(w4.y & 0xffff0000u);
                  q2 += __uint_as_float(w4.z << 16) * __uint_as_float(w4.z << 16) + __uint_as_float(w4.z & 0xffff0000u) * __uint_as_float(w4.z & 0xffff0000u);
                  q2 += __uint_as_float(w4.w << 16) * __uint_as_float(w4.w << 16) + __uint_as_float(w4.w & 0xffff0000u) * __uint_as_float(w4.w & 0xffff0000u); }
              q2 += __shfl_xor(q2, 1);
#pragma unroll
              for (int o_ = 2; o_ < 64; o_ <<= 1) q2 = fmaxf(q2, __shfl_xor(q2, o_));
              if (lane == 0) part[1024 + wave] = q2; }
            LDS_WAIT(); __syncthreads();
            if (tid < 128) { float s = 0.f;
#pragma unroll
                for (int w = 0; w < 8; ++w) s += part[w * 128 + tid];
                KM[(size_t)u * HD + tid] = s * (1.0f / MB); }
            if (tid == 128) { float q2 = part[1024];
#pragma unroll
                for (int w = 1; w < 8; ++w) q2 = fmaxf(q2, part[1024 + w]);
                KN[u] = q2; }
            LDS_WAIT(); __syncthreads();
        }
    }
    SEAM_BG(4);
    if (IN(5)) {
        const bool x8 = (G & 7) == 0; const int grp = x8 ? (bid & 7) : 0, ngrp = x8 ? 8 : 1;
        const int nmo = 512 / ngrp, nsb = 1024 / ngrp;
        gu32* qhead = ctl + CW_QUEUE + 64 * grp;
#pragma unroll 1
        for (;;) {
            if (tid == 0) MISC[16] = __hip_atomic_fetch_add(qhead, 1u, RLX_AGENT);
            LDS_WAIT(); __syncthreads();
            const int i = (int)MISC[16];
            __syncthreads();
            if (i >= nmo) break;
            const int pr = i & 7, kk = i >> 3, bh = x8 ? (grp >> 1) * NH + ((grp & 1) + 2 * (7 - kk)) : 63 - kk, b = bh / NH, h = bh % NH;
            const float slope = exp2f(-0.5f * (float)(h + 1));
            const bf16* base = QKV + ((size_t)(h >> 1) * M + (size_t)b * SEQ) * 2 * HD + (h & 1) * HD;
#pragma unroll 1
            for (int pass = 0; pass < 2; ++pass) { const int qb = pass ? pr : 15 - pr;
                att::attn_unit<0>(base, base + (size_t)1 * M * AW, base + (size_t)2 * M * AW, ATT + (size_t)b * SEQ * DM + h * HD, qb, slope, KM + (size_t)bh * NBLK * HD, KN + bh * NBLK, (LAS char*)(lds + RING_OFF)); }
        }
#pragma unroll 1
        for (;;) {
            if (tid == 0) MISC[16] = __hip_atomic_fetch_add(qhead + 64 * 8, 1u, RLX_AGENT);
            LDS_WAIT(); __syncthreads();
            const int j = (int)MISC[16];
            __syncthreads();
            if (j >= nsb) break;
            const int bh = (x8 ? grp * 8 : 0) + (j >> 4), qb = j & 15, b = bh / NH, h = bh % NH;
            const bf16* base = QKV + ((size_t)(h >> 1) * M + (size_t)b * SEQ) * 2 * HD + (h & 1) * HD;
            att::attn_unit<1>(base + (size_t)3 * M * AW, base + (size_t)4 * M * AW, base + (size_t)5 * M * AW, ATT + (size_t)b * SEQ * DM + AW + h * HD, qb, 0.f, nullptr, nullptr, (LAS char*)(lds + RING_OFF));
        }
    }
    if (IN(5)) DRAIN_BG(T_BR);
    SEAM_BG(5);
    if (IN(6)) {
        { pg8::Gemm g{ATT, WBR, M, DM, AW, DM, 2 * AW}; pg8::StaticOrder S; S.init(M, DM, G, bid, WGM_ALL);
          pg8::EpiGate<false> E{GAB, 2 * DM, Z, DM};
          pg8::gemm_phase<pg8::EpiGate<false>, pg8::StaticOrder, PG8_ALIGN, PG8_SP2>(lds + RING_OFF, g, S, E); }
        { pg8::Gemm g{ATT + AW, WBR + AW, M, DM, AW, DM, 2 * AW}; pg8::StaticOrder S; S.init(M, DM, G, bid, WGM_ALL);
          pg8::EpiGate<true> E{GAB + DM, 2 * DM, Z, DM};
          pg8::gemm_phase<pg8::EpiGate<true>, pg8::StaticOrder, PG8_ALIGN, PG8_SP2>(lds + RING_OFF, g, S, E); }
    }
    if (IN(6)) DRAIN_BG(T_OUT);
    SEAM_BG(6);
    if (IN(7)) {
        { pg8::Gemm g{Z, WOUT, M, DM, DM, DM, DM}; pg8::StaticOrder S; S.init(M, DM, G, bid, WGM_ALL);
          pg8::EpiResidBf E{HB, HB, DM, 1.0f, SS2};
          pg8::gemm_phase<pg8::EpiResidBf, pg8::StaticOrder, PG8_ALIGN, PG8_SP2>(lds + RING_OFF, g, S, E); }
    }
    if (IN(7)) DRAIN_BG(T_GU2);
    SEAM_BG(7);
    if (IN(8)) {
        if (!tailfill) { pg8::Gemm g{PBF, WPE, M, DM, PLE, PLE, PLE}; pg8::StaticOrder S; S.init(M, DM, G, bid, WGM_ALL);
          pg8::EpiBf16 E{PE, DM, pg8::RowScale{nullptr, rsl, -1}, 256, 1 << 30, nullptr, 0};
          pg8::gemm_phase<pg8::EpiBf16, pg8::StaticOrder, PG8_ALIGN, PG8_SP2>(lds + RING_OFF, g, S, E); }
        { pg8::Gemm g{HB, WGU2, M, 2 * DFF, DM, DM, DM}; pg8::StaticOrder S; S.init(M, 2 * DFF, G, bid, WGM_ALL);
          PREP_RS(RS, SS2, S); pg8::EpiSwiGLU E{ACT, DFF, RS};
          pg8::gemm_phase<pg8::EpiSwiGLU, pg8::StaticOrder, PG8_ALIGN, PG8_SP2>(lds + RING_OFF, g, S, E); }
        if (tailfill && bid >= 128) {
          pg8::Gemm g{PBF, WPE, M, DM, PLE, PLE, PLE}; pg8::StaticOrder S; S.init(M, DM, 128, bid - 128, WGM_ALL); S.L0 = 256;
          pg8::EpiBf16 E{PE, DM, pg8::RowScale{nullptr, rsl, -1}, 256, 1 << 30, nullptr, 0};
          pg8::gemm_phase<pg8::EpiBf16, pg8::StaticOrder, PG8_ALIGN, PG8_SP2>(lds + RING_OFF, g, S, E); }
    }
    if (IN(8)) DRAIN_BG(T_D2);
    SEAM_BG(8);
    if (IN(9)) {
        pg8::Gemm g{ACT, WD2, M, DM, DFF, DFF, DFF}; g.krev = 1; pg8::StaticOrder S; S.init(M, DM, G, bid, WGM_DOWN);
        pg8::EpiResidBf E{HB, HB, DM, 0.5f, SS3};
        pg8::gemm_phase<pg8::EpiResidBf, pg8::StaticOrder, PG8_ALIGN, PG8_SP2>(lds + RING_OFF, g, S, E);
    }
    if (IN(9)) DRAIN_BG(NT_BG);
    SEAM(9);
    if (IN(10)) {
        pg8::Gemm g{HB, WPG, M, DM, DM, DM, DM}; pg8::StaticOrder S; S.init(M, DM, G, bid, WGM_ALL);
        PREP_RS(RS, SS3, S); pg8::EpiPleOut E{HB, PE, HF, DM, RS};
        pg8::gemm_phase<pg8::EpiPleOut, pg8::StaticOrder, PG8_ALIGN, PG8_SP2>(lds + RING_OFF, g, S, E);
    }
    SEAM(10);
    if (IN(11)) { for (int m = gw; m < M; m += NGW) rms_row_out(HF + (size_t)m * DM, out + (size_t)m * DM, g_fin, lane); }
#undef IN
#undef SEAM
#undef SEAM_BG
#undef DRAIN_BG
#undef TRY_BG
#undef BG_CONV
}

extern "C" void kernel_launch(void* const* d_in, const int* in_sizes, int n_in, void* d_out, int out_size, void* d_ws, size_t ws_size, hipStream_t stream) {
    static int grid = 0;
    if (grid == 0) {
        if (n_in != 19 || in_sizes[0] != M * DM || out_size != M * DM || ws_size < WS_END) { fprintf(stderr, "kernel_launch: shape mismatch (n_in %d, in0 %d, out %d, ws %zu, need %zu); nothing launched\n", n_in, n_in > 0 ? in_sizes[0] : -1, out_size, ws_size, (size_t)WS_END); grid = -1; return; }
        int dev = 0, cus = 0, per_cu = 0;
        if (hipGetDevice(&dev) != hipSuccess || hipDeviceGetAttribute(&cus, hipDeviceAttributeMultiprocessorCount, dev) != hipSuccess) { fprintf(stderr, "kernel_launch: device query failed\n"); grid = -1; return; }
        if (hipFuncSetAttribute((const void*)mega_fwd, hipFuncAttributeMaxDynamicSharedMemorySize, LDS_BYTES) != hipSuccess) { fprintf(stderr, "kernel_launch: hipFuncSetAttribute failed\n"); grid = -1; return; }
        if (hipOccupancyMaxActiveBlocksPerMultiprocessor(&per_cu, (const void*)mega_fwd, NWAVES * 64, LDS_BYTES) != hipSuccess || per_cu < 1) fprintf(stderr, "kernel_launch: note: occupancy query reports %d blocks per CU\n", per_cu);
        (void)hipGetLastError();
        grid = cus;
        fprintf(stderr, "kernel_launch: grid %d, ws %zu (need %zu)\n", grid, ws_size, (size_t)WS_END);
    }
    if (grid < 0) return;
    if (hipMemsetAsync((char*)d_ws + WS_CTL, 0, CTL_ZERO_BYTES, stream) != hipSuccess) { fprintf(stderr, "kernel_launch: memset failed\n"); return; }
    Args a{};
    for (int i = 0; i < 19; ++i) a.in[i] = (const float*)d_in[i];
    a.out = (float*)d_out; a.ws = (unsigned char*)d_ws;
    for (int li = 0; li < MK_N_LAUNCHES; ++li) {
        a.ph_lo = (MK_N_LAUNCHES == 1) ? 0 : li; a.ph_hi = (MK_N_LAUNCHES == 1) ? N_PHASES : li + 1;
        hipLaunchKernelGGL(mega_fwd, dim3(grid), dim3(NWAVES * 64), LDS_BYTES, stream, a);
        const hipError_t le = hipPeekAtLastError();
        if (le != hipSuccess) { fprintf(stderr, "kernel_launch: launch %d failed: %s\n", li, hipGetErrorName(le)); break; }
    }
}
```
